# Optimizing an MI355X kernel written in HIP

```python
import jax, jax.numpy as jnp
from jax import lax
import numpy as np

D_MODEL = 1024
BATCH = 4
SEQ = 4096
DEPTH = 1

SSD_EXPAND = 2
SSD_D_INNER = SSD_EXPAND * D_MODEL
SSD_HEAD_DIM = 64
SSD_HEADS = SSD_D_INNER // SSD_HEAD_DIM
SSD_GROUPS = 4
SSD_HEADS_PER_GROUP = SSD_HEADS // SSD_GROUPS
SSD_STATE = 128
SSD_CONV = 4
SSD_CHUNK = 128
SSD_BC = SSD_GROUPS * SSD_STATE
SSD_XBC = SSD_D_INNER + 2 * SSD_BC
SSD_IN = SSD_D_INNER + SSD_XBC + SSD_HEADS

SGU_WIDTH = D_MODEL
SGU_GROUPS = 8
SGU_GROUP_DIM = SGU_WIDTH // SGU_GROUPS
SGU_CHUNK = 128
SGU_IN = 2 * SGU_WIDTH

N_BRANCH = 2
GATE_IN = N_BRANCH * D_MODEL
IN_COLS = SSD_IN + SGU_IN + GATE_IN
MIX_WIDTH = SSD_D_INNER + SGU_WIDTH

D_FF = 2816
FFN_CONV = 3

NORM_EPS = 1e-6
LN_EPS = 1e-5

kernel_name = "hybrid_ssd_sgu_convffn_block"


def rms_norm(x, w, eps=NORM_EPS):
    xf = x.astype(jnp.float32)
    y = xf * lax.rsqrt(jnp.mean(xf * xf, axis=-1, keepdims=True) + eps)
    return (y * w.astype(jnp.float32)).astype(x.dtype)


def layer_norm(x, w, b, eps=LN_EPS):
    xf = x.astype(jnp.float32)
    mu = jnp.mean(xf, axis=-1, keepdims=True)
    var = jnp.mean(jnp.square(xf - mu), axis=-1, keepdims=True)
    y = (xf - mu) * lax.rsqrt(var + eps) * w.astype(jnp.float32) + b.astype(jnp.float32)
    return y.astype(x.dtype)


def causal_dwconv(x, w, b):
    k = w.shape[0]
    s = x.shape[1]
    xp = jnp.pad(x, ((0, 0), (k - 1, 0), (0, 0)))
    y = b
    for i in range(k):
        y = y + w[i] * xp[:, i:i + s]
    return y


def segsum_exp(a_cum):
    t = a_cum.shape[-1]
    diff = a_cum[..., :, None] - a_cum[..., None, :]
    mask = jnp.tril(jnp.ones((t, t), dtype=bool))
    return jnp.exp(jnp.where(mask, diff, -jnp.inf))


def ssd_chunked(xh, dt, a, b_mat, c_mat):
    bsz, s = xh.shape[0], xh.shape[1]
    nc = s // SSD_CHUNK
    G, R, L, P, N = SSD_GROUPS, SSD_HEADS_PER_GROUP, SSD_CHUNK, SSD_HEAD_DIM, SSD_STATE
    xdt = (xh.astype(jnp.float32) * dt[..., None]).reshape(bsz, nc, L, G, R, P)
    adt = (dt * a).reshape(bsz, nc, L, G, R)
    a_cum = jnp.cumsum(jnp.transpose(adt, (0, 3, 4, 1, 2)), axis=-1)
    bm = b_mat.reshape(bsz, nc, L, G, N)
    cm = c_mat.reshape(bsz, nc, L, G, N)
    cb = jnp.einsum('bclgn,bcsgn->bgcls', cm, bm)
    decay = segsum_exp(a_cum)
    y_diag = jnp.einsum('bgcls,bgrcls,bcsgrp->bclgrp', cb, decay, xdt)
    decay_states = jnp.exp(a_cum[..., -1:] - a_cum)
    states = jnp.einsum('bcsgn,bgrcs,bcsgrp->bcgrpn', bm, decay_states, xdt)
    chunk_tot = jnp.pad(a_cum[..., -1], ((0, 0), (0, 0), (0, 0), (1, 0)))
    decay_chunk = segsum_exp(jnp.cumsum(chunk_tot, axis=-1))
    states = jnp.concatenate([jnp.zeros_like(states[:, :1]), states], axis=1)
    states = jnp.einsum('bgrzc,bcgrpn->bzgrpn', decay_chunk, states)[:, :-1]
    y_off = jnp.einsum('bclgn,bcgrpn,bgrcl->bclgrp', cm, states, jnp.exp(a_cum))
    return (y_diag + y_off).reshape(bsz, s, SSD_HEADS, P)


def ssd_branch(z, xbc, dt_raw, conv_w, conv_b, dt_bias, a_log, d_skip, norm_w):
    xbc = jax.nn.silu(causal_dwconv(xbc, conv_w, conv_b))
    xs, b_mat, c_mat = jnp.split(xbc, [SSD_D_INNER, SSD_D_INNER + SSD_BC], axis=-1)
    bsz, s = xs.shape[0], xs.shape[1]
    xh = xs.reshape(bsz, s, SSD_HEADS, SSD_HEAD_DIM)
    dt = jax.nn.softplus(dt_raw.astype(jnp.float32) + dt_bias.astype(jnp.float32))
    a = -jnp.exp(a_log.astype(jnp.float32))
    y = ssd_chunked(xh, dt, a,
                    b_mat.reshape(bsz, s, SSD_GROUPS, SSD_STATE),
                    c_mat.reshape(bsz, s, SSD_GROUPS, SSD_STATE))
    y = y + d_skip.astype(jnp.float32)[:, None] * xh.astype(jnp.float32)
    y = y.reshape(bsz, s, SSD_D_INNER).astype(xs.dtype)
    return rms_norm(y * jax.nn.silu(z), norm_w)


def sgu_branch(uv, ln_w, ln_b, w_spatial, b_spatial):
    uv = jax.nn.gelu(uv)
    u, v = jnp.split(uv, 2, axis=-1)
    v = layer_norm(v, ln_w, ln_b)
    bsz, s = v.shape[0], v.shape[1]
    nc = s // SGU_CHUNK
    vc = v.reshape(bsz, nc, SGU_CHUNK, SGU_GROUPS, SGU_GROUP_DIM)
    w_causal = w_spatial * jnp.tril(jnp.ones((SGU_CHUNK, SGU_CHUNK), w_spatial.dtype))
    mixed = jnp.einsum('gts,bcsgd->bctgd', w_causal, vc) + b_spatial.T[None, None, :, :, None]
    return u * mixed.reshape(bsz, s, SGU_WIDTH)


def setup_inputs(seed: int = 0) -> dict:
    key = jax.random.key(seed)
    ks = jax.random.split(key, 24)
    f32 = jnp.float32

    def nrm(k, shape, scale):
        return jax.random.normal(k, shape, f32) * scale

    x = jax.random.normal(ks[0], (BATCH, SEQ, D_MODEL), f32)
    norm1_w = 1.0 + nrm(ks[1], (DEPTH, D_MODEL), 0.02)
    w_in = nrm(ks[2], (DEPTH, D_MODEL, IN_COLS), D_MODEL ** -0.5)
    b_gate = nrm(ks[3], (DEPTH, GATE_IN), 0.1)
    conv_a_w = nrm(ks[4], (DEPTH, SSD_CONV, SSD_XBC), SSD_CONV ** -0.5)
    conv_a_b = nrm(ks[5], (DEPTH, SSD_XBC), 0.02)
    dt0 = jnp.exp(jax.random.uniform(ks[6], (DEPTH, SSD_HEADS), f32,
                                     float(np.log(1e-3)), float(np.log(1e-1))))
    dt_bias = dt0 + jnp.log(-jnp.expm1(-dt0))
    a_log = jnp.log(jax.random.uniform(ks[7], (DEPTH, SSD_HEADS), f32, 1.0, 16.0))
    d_skip = 1.0 + nrm(ks[8], (DEPTH, SSD_HEADS), 0.1)
    ssd_norm_w = 1.0 + nrm(ks[9], (DEPTH, SSD_D_INNER), 0.02)
    uv_b = nrm(ks[10], (DEPTH, SGU_IN), 0.02)
    v_ln_w = 1.0 + nrm(ks[11], (DEPTH, SGU_WIDTH), 0.02)
    v_ln_b = nrm(ks[12], (DEPTH, SGU_WIDTH), 0.02)
    w_spatial = nrm(ks[13], (DEPTH, SGU_GROUPS, SGU_CHUNK, SGU_CHUNK), SGU_CHUNK ** -0.5)
    b_spatial = 1.0 + nrm(ks[14], (DEPTH, SGU_GROUPS, SGU_CHUNK), 0.1)
    w_branch = jnp.concatenate(
        [nrm(ks[15], (DEPTH, SSD_D_INNER, D_MODEL), SSD_D_INNER ** -0.5),
         nrm(ks[16], (DEPTH, SGU_WIDTH, D_MODEL), SGU_WIDTH ** -0.5)], axis=1)
    w_out = nrm(ks[17], (DEPTH, D_MODEL, D_MODEL), D_MODEL ** -0.5)
    norm2_w = 1.0 + nrm(ks[18], (DEPTH, D_MODEL), 0.02)
    w_up = nrm(ks[19], (DEPTH, D_MODEL, 2 * D_FF), D_MODEL ** -0.5)
    conv_f_w = nrm(ks[20], (DEPTH, FFN_CONV, 2 * D_FF), FFN_CONV ** -0.5)
    conv_f_b = nrm(ks[21], (DEPTH, 2 * D_FF), 0.02)
    w_down = nrm(ks[22], (DEPTH, D_FF, D_MODEL), D_FF ** -0.5)
    final_norm_w = 1.0 + nrm(ks[23], (D_MODEL,), 0.02)
    return {"x": x, "norm1_w": norm1_w, "w_in": w_in, "b_gate": b_gate,
            "conv_a_w": conv_a_w, "conv_a_b": conv_a_b, "dt_bias": dt_bias,
            "a_log": a_log, "d_skip": d_skip, "ssd_norm_w": ssd_norm_w,
            "uv_b": uv_b, "v_ln_w": v_ln_w, "v_ln_b": v_ln_b,
            "w_spatial": w_spatial, "b_spatial": b_spatial, "w_branch": w_branch,
            "w_out": w_out, "norm2_w": norm2_w, "w_up": w_up, "conv_f_w": conv_f_w,
            "conv_f_b": conv_f_b, "w_down": w_down, "final_norm_w": final_norm_w}


def reference(x, norm1_w, w_in, b_gate, conv_a_w, conv_a_b, dt_bias, a_log, d_skip,
              ssd_norm_w, uv_b, v_ln_w, v_ln_b, w_spatial, b_spatial, w_branch, w_out,
              norm2_w, w_up, conv_f_w, conv_f_b, w_down, final_norm_w):
    h = x
    for l in range(DEPTH):
        n = rms_norm(h, norm1_w[l])
        proj = n @ w_in[l]
        z, xbc, dt_raw, uv, gates = jnp.split(
            proj, [SSD_D_INNER, SSD_D_INNER + SSD_XBC, SSD_IN, SSD_IN + SGU_IN], axis=-1)
        y_a = ssd_branch(z, xbc, dt_raw, conv_a_w[l], conv_a_b[l], dt_bias[l],
                         a_log[l], d_skip[l], ssd_norm_w[l])
        y_b = sgu_branch(uv + uv_b[l], v_ln_w[l], v_ln_b[l],
                         w_spatial[l], b_spatial[l])
        g_a, g_b = jnp.split(jax.nn.sigmoid(gates + b_gate[l]), 2, axis=-1)
        p_a = y_a @ w_branch[l, :SSD_D_INNER]
        p_b = y_b @ w_branch[l, SSD_D_INNER:]
        h = h + (g_a * p_a + g_b * p_b) @ w_out[l]
        n = rms_norm(h, norm2_w[l])
        up = causal_dwconv(n @ w_up[l], conv_f_w[l], conv_f_b[l])
        a_up, v_up = jnp.split(up, 2, axis=-1)
        h = h + (jax.nn.silu(a_up) * v_up) @ w_down[l]
    return rms_norm(h, final_norm_w)
```

```cpp
#include <hip/hip_runtime.h>
#include <cstdio>
#include <cstdint>

#ifndef MK_N_LAUNCHES
#define MK_N_LAUNCHES 9
#endif

constexpr int D = 1024, SEQ = 4096, BATCH = 4, M = BATCH * SEQ;
constexpr int DI = 2048, NH = 32, HD = 64, NG = 4, NS = 128, XBCW = 3072, CHUNK = 128;
constexpr int N1 = 7168;
constexpr int FF = 2816;
constexpr int ACAT_LD = 4096;
constexpr int BCAT_LD = 5120;
constexpr float NORM_EPS = 1e-6f, LN_EPS = 1e-5f;

constexpr size_t MiB = 1u << 20;
constexpr size_t WS_CTL = 0, CTL_ZERO_BYTES = 64 * 1024;
constexpr size_t WS_BCAT = 1 * MiB, WS_WOUT = 11 * MiB, WS_WUP = 13 * MiB, WS_WDOWN = 24 * MiB;
constexpr size_t WS_SS2 = 29 * MiB + 512 * 1024, WS_SS3 = 30 * MiB + 512 * 1024;
constexpr size_t WS_ACAT = 32 * MiB, WS_XBC = 160 * MiB, WS_END = 256 * MiB;
constexpr size_t WS_T = 160 * MiB, WS_G = 192 * MiB, WS_H = 192 * MiB, WS_HB = 32 * MiB, WS_ACT = 64 * MiB;
constexpr size_t DO_V = 0, DO_W1T = 32 * MiB, DO_DT = 48 * MiB, DO_ACUM = 50 * MiB, DO_SSQ = 52 * MiB, DO_HALO = 56 * MiB, DO_VST = 59 * MiB;

namespace pg8 {
#define PG8_LAS __attribute__((address_space(3)))
typedef unsigned short bf16_t;
typedef short bf16x8 __attribute__((ext_vector_type(8)));
typedef float f32x4 __attribute__((ext_vector_type(4)));
typedef float f32x2 __attribute__((ext_vector_type(2)));
typedef unsigned u32x4 __attribute__((ext_vector_type(4)));
typedef unsigned u32x2 __attribute__((ext_vector_type(2)));
constexpr int BM = 256, BK = 64, HALF = 128, HTB = HALF * BK * 2, STAGE_BYTES = 8 * HTB, NXCD = 8, WGM = 8;

__host__ __device__ __forceinline__ int lds_byte(int r, int c) { const int st = (r >> 4) * 2 + (c >> 5), rr = r & 15, cc = c & 31, ob = rr * 64 + cc * 2; return st * 1024 + (ob ^ (((ob >> 9) & 1) << 5)); }
__host__ __device__ __forceinline__ void stage_rc(int b, int& R, int& C) { const int st = b / 1024, sb = b % 1024, swz = sb ^ (((sb >> 9) & 1) << 5); R = (st >> 1) * 16 + swz / 64; C = (st & 1) * 32 + (swz % 64) / 2; }
__host__ __device__ __forceinline__ int perm32(int rho) { const int n = rho >> 4, i = rho & 15; return 8 * (i >> 2) + 4 * n + (i & 3); }

struct Unit { const char* A; const char* B; int nt, pm, pn, kind; };

__device__ __forceinline__ void tile_of(int L, int nM, int nN, int& pm, int& pn) {
    const int nwg = nM * nN; int wgid = L; { const int q = nwg / NXCD, r = nwg % NXCD, xcd = wgid % NXCD, off = wgid / NXCD; wgid = (xcd < r ? xcd * (q + 1) : r * (q + 1) + (xcd - r) * q) + off; }
    const int nig = WGM * nN, gid = wgid / nig, fm = gid * WGM, gsz = (nM - fm) < WGM ? (nM - fm) : WGM;
    pm = fm + ((wgid % nig) % gsz); pn = (wgid % nig) / gsz;
}

typedef __bf16 bf16x2_t __attribute__((ext_vector_type(2)));
__device__ __forceinline__ unsigned cvt_pk_bf16(float lo, float hi) { const f32x2 v = {lo, hi}; return __builtin_bit_cast(unsigned, __builtin_convertvector(v, bf16x2_t)); }
__device__ __forceinline__ float bf_lo(unsigned w) { return __builtin_bit_cast(float, w << 16); }
__device__ __forceinline__ float bf_hi(unsigned w) { return __builtin_bit_cast(float, w & 0xffff0000u); }
__device__ __forceinline__ float fast_sigmoid(float x) { return __builtin_amdgcn_rcpf(1.0f + __builtin_amdgcn_exp2f(-1.44269504089f * x)); }
__device__ __forceinline__ float fast_silu(float x) { return x * fast_sigmoid(x); }
__device__ __forceinline__ float gelu_tanh(float x) { const float u = 1.5957691216057308f * (x + 0.044715f * x * x * x); return x * fast_sigmoid(u); }

template <class Epi, class Sched, bool ALIGN_EPI, bool MAP62>
__device__ __forceinline__ void gemm_phase(PG8_LAS unsigned char* lds, const int lda, const int ldb, const Sched& S, const Epi& E) {
    const int tid = threadIdx.x, wid = __builtin_amdgcn_readfirstlane(tid >> 6), lane = tid & 63, wr = wid >> 2, wc = wid & 3, fr = lane & 15, fq = lane >> 4;
    unsigned voffA[2], voffB[2];
#pragma unroll
    for (int i = 0; i < 2; ++i) { int R, C; stage_rc(tid * 16 + i * 8192, R, C); const int Rb = Epi::PERM ? ((R & ~31) + perm32(R & 31)) : R; const int Ra = MAP62 ? (R - 2 * (R >> 6)) : R;
        voffA[i] = (unsigned)(Ra * lda + C) * 2u; voffB[i] = (unsigned)(Rb * ldb + C) * 2u; }
    const size_t kstep = (size_t)(BK * 2);
    const size_t hstepA = (size_t)(MAP62 ? 124 : 128) * lda * 2, hstepB = (size_t)HALF * ldb * 2;
    const unsigned ldsw = (unsigned)wid * 1024u;
    const int aoff = lds_byte(wr * 64 + fr, fq * 8), boff = lds_byte(wc * 32 + fr, fq * 8);
#define PG8_SA(b, h) (((b) * 2 + (h)) * HTB)
#define PG8_SB(b, h) ((4 + (b) * 2 + (h)) * HTB)
#define PG8_STAGE(bufoff, gbase, voff) do { _Pragma("unroll") for (int _i = 0; _i < 2; ++_i) \
        __builtin_amdgcn_global_load_lds((const unsigned*)((const char*)(gbase) + (voff)[_i]), (PG8_LAS unsigned*)(lds + (bufoff) + ldsw + _i * 8192), 16, 0, 0); } while (0)
#define PG8_LDA(dst, b, h) do { _Pragma("unroll") for (int m = 0; m < 4; ++m) _Pragma("unroll") for (int k = 0; k < 2; ++k) dst[m][k] = *(const PG8_LAS bf16x8*)(lds + PG8_SA(b, h) + aoff + m * 2048 + k * 1024); } while (0)
#define PG8_LDB(dst, b, h) do { _Pragma("unroll") for (int n = 0; n < 2; ++n) _Pragma("unroll") for (int k = 0; k < 2; ++k) dst[n][k] = *(const PG8_LAS bf16x8*)(lds + PG8_SB(b, h) + boff + n * 2048 + k * 1024); } while (0)
#define PG8_MMA(ai, bj, At, Bt) do { __builtin_amdgcn_s_setprio(1); _Pragma("unroll") for (int m = 0; m < 4; ++m) _Pragma("unroll") for (int n = 0; n < 2; ++n) _Pragma("unroll") for (int k = 0; k < 2; ++k) \
        acc[ai][bj][m][n] = __builtin_amdgcn_mfma_f32_16x16x32_bf16(Bt[n][k], At[m][k], acc[ai][bj][m][n], 0, 0, 0); __builtin_amdgcn_s_setprio(0); } while (0)
#define PG8_WAIT_V(n) asm volatile("s_waitcnt vmcnt(" #n ")" ::: "memory")
#define PG8_WAIT_L(n) asm volatile("s_waitcnt lgkmcnt(" #n ")" ::: "memory")
#define PG8_BAR __builtin_amdgcn_s_barrier()
#define PG8_SCHED __builtin_amdgcn_sched_barrier(0)
    Unit cur, nxt; int ui = 0;
    if (!S.next(0, cur)) return;
    f32x4 acc[2][2][4][2];
#pragma unroll
    for (int a = 0; a < 2; ++a)
#pragma unroll
        for (int b = 0; b < 2; ++b)
#pragma unroll
            for (int m = 0; m < 4; ++m)
#pragma unroll
                for (int n = 0; n < 2; ++n) acc[a][b][m][n] = (f32x4){0.f, 0.f, 0.f, 0.f};
    bf16x8 At[4][2], B0[2][2], B1[2][2];
    const char* cA = cur.A; const char* cB = cur.B;
    PG8_STAGE(PG8_SB(0, 0), cB, voffB); PG8_STAGE(PG8_SB(0, 1), cB + hstepB, voffB); PG8_STAGE(PG8_SA(0, 0), cA, voffA); PG8_STAGE(PG8_SA(0, 1), cA + hstepA, voffA);
    if (wr == 1) PG8_BAR;
    PG8_WAIT_V(2); PG8_BAR;
    PG8_STAGE(PG8_SB(1, 0), cB + kstep, voffB); PG8_STAGE(PG8_SA(1, 0), cA + kstep, voffA); PG8_STAGE(PG8_SB(1, 1), cB + hstepB + kstep, voffB);
    PG8_WAIT_V(6); PG8_BAR;
    for (;;) {
        const bool has_next = S.next(ui + 1, nxt);
        const char* nA = has_next ? nxt.A : cA; const char* nB = has_next ? nxt.B : cB;
        const int nt = cur.nt;
        for (int t = 0; t < nt; t += 2) {
            const bool last = (t == nt - 2);
            const char* a1 = cA + (size_t)(t + 1) * kstep;
            const char* a2 = last ? nA : cA + (size_t)(t + 2) * kstep; const char* b2 = last ? nB : cB + (size_t)(t + 2) * kstep;
            const char* a3 = a2 + kstep; const char* b3 = b2 + kstep;
            PG8_LDB(B0, 0, 0); PG8_LDB(B1, 0, 1); PG8_SCHED; PG8_LDA(At, 0, 0); PG8_STAGE(PG8_SA(1, 1), a1 + hstepA, voffA);
            PG8_WAIT_V(8); PG8_WAIT_L(0); PG8_BAR; PG8_MMA(0, 0, At, B0); PG8_MMA(0, 1, At, B1); PG8_BAR; PG8_SCHED;
            PG8_LDA(At, 0, 1); PG8_STAGE(PG8_SB(0, 0), b2, voffB); PG8_STAGE(PG8_SB(0, 1), b2 + hstepB, voffB); PG8_STAGE(PG8_SA(0, 0), a2, voffA);
            PG8_WAIT_V(8); PG8_WAIT_L(0); PG8_BAR; PG8_MMA(1, 0, At, B0); PG8_MMA(1, 1, At, B1); PG8_BAR; PG8_SCHED;
            PG8_LDB(B0, 1, 0); PG8_LDB(B1, 1, 1); PG8_SCHED; PG8_LDA(At, 1, 0); PG8_STAGE(PG8_SA(0, 1), a2 + hstepA, voffA);
            PG8_WAIT_V(8); PG8_WAIT_L(0); PG8_BAR; PG8_MMA(0, 0, At, B0); PG8_MMA(0, 1, At, B1); PG8_BAR; PG8_SCHED;
            PG8_LDA(At, 1, 1); PG8_STAGE(PG8_SB(1, 0), b3, voffB); PG8_STAGE(PG8_SB(1, 1), b3 + hstepB, voffB); PG8_STAGE(PG8_SA(1, 0), a3, voffA);
            PG8_WAIT_V(8); PG8_WAIT_L(0); PG8_BAR; PG8_MMA(1, 0, At, B0); PG8_MMA(1, 1, At, B1); PG8_BAR; PG8_SCHED;
        }
        if constexpr (ALIGN_EPI) { if (wr == 0) PG8_BAR; }
        E(acc, cur, wr, wc, fr, fq);
        if (!has_next) break;
#pragma unroll
        for (int a = 0; a < 2; ++a)
#pragma unroll
            for (int b = 0; b < 2; ++b)
#pragma unroll
                for (int m = 0; m < 4; ++m)
#pragma unroll
                    for (int n = 0; n < 2; ++n) acc[a][b][m][n] = (f32x4){0.f, 0.f, 0.f, 0.f};
        cur = nxt; cA = nA; cB = nB; ++ui;
        if constexpr (ALIGN_EPI) { if (wr == 1) PG8_BAR; }
    }
    PG8_WAIT_V(0);
    if constexpr (!ALIGN_EPI) { if (wr == 0) PG8_BAR; }
    PG8_BAR;
#undef PG8_SA
#undef PG8_SB
#undef PG8_STAGE
#undef PG8_LDA
#undef PG8_LDB
#undef PG8_MMA
#undef PG8_WAIT_V
#undef PG8_WAIT_L
#undef PG8_BAR
#undef PG8_SCHED
}
}

using pg8::bf16_t; using pg8::f32x4; using pg8::f32x2; using pg8::u32x4; using pg8::u32x2; using pg8::bf16x8; using pg8::Unit;
using pg8::cvt_pk_bf16; using pg8::bf_lo; using pg8::bf_hi; using pg8::fast_sigmoid; using pg8::fast_silu; using pg8::gelu_tanh;

constexpr int NWAVES = 8;
constexpr int RING_BYTES = 131072, LDSCTL_OFF = RING_BYTES, MISC_OFF = LDSCTL_OFF + 320, LDS_BYTES = 147456;
#define GAS __attribute__((address_space(1)))
#define LAS __attribute__((address_space(3)))
typedef GAS unsigned gu32;
#define RLX_AGENT __ATOMIC_RELAXED, __HIP_MEMORY_SCOPE_AGENT
#define LDS_WAIT() asm volatile("s_waitcnt lgkmcnt(0)" ::: "memory")
__device__ __forceinline__ unsigned f2bf(float f) { unsigned u = __builtin_bit_cast(unsigned, f); return (u + 0x7fffu + ((u >> 16) & 1u)) >> 16; }
__device__ __forceinline__ unsigned pk2(float lo, float hi) { return f2bf(lo) | (f2bf(hi) << 16); }
__device__ __forceinline__ float bf2f(bf16_t h) { return __builtin_bit_cast(float, (unsigned)h << 16); }
__device__ __forceinline__ float wave_sum(float v) {
#pragma unroll
    for (int o = 1; o < 64; o <<= 1) v += __shfl_xor(v, o);
    return v;
}

#define XB_TMO      128
#define XB_XCNT(j)  (256  + 64 * (j))
#define XB_XSUB(j)  (1280 + 64 * (j))
#define XB_XGEN(j)  (2304 + 64 * (j))
#define XB_TOP      3328
#define XB_TOPGEN   3392
#define XCD_BAR_WORDS 3456
#define XB_SPIN_CAP (1u << 20)
__device__ __forceinline__ unsigned xb_ld(unsigned* p)              { return __hip_atomic_load(p, __ATOMIC_RELAXED, __HIP_MEMORY_SCOPE_AGENT); }
__device__ __forceinline__ unsigned xb_add(unsigned* p, unsigned v) { return __hip_atomic_fetch_add(p, v, __ATOMIC_RELAXED, __HIP_MEMORY_SCOPE_AGENT); }
__device__ __forceinline__ unsigned xb_xcc_id() { return (unsigned)__builtin_amdgcn_s_getreg((3 << 11) | 20) & 0xFu; }
#define XB_SPIN(cond, bar) do { unsigned _sp = 0; while (cond) { __builtin_amdgcn_s_sleep(1); \
    if ((++_sp & 255u) == 0u) { if (xb_ld(&(bar)[XB_TMO])) break; if (_sp > XB_SPIN_CAP) { atomicAdd(&(bar)[XB_TMO], 1u); break; } } } } while (0)
struct XcdBarrier { unsigned* bar; unsigned x; volatile LAS unsigned* st; };
__device__ __forceinline__ XcdBarrier xcd_barrier_post(unsigned* bar, volatile LAS unsigned* st) {
    XcdBarrier b; b.bar = bar; b.x = xb_xcc_id(); b.st = st;
    if (threadIdx.x == 0) (void)xb_add(&bar[XB_XCNT(b.x)], 1u);
    return b;
}
__device__ __forceinline__ void xcd_barrier_complete(unsigned* bar, unsigned x, unsigned& nloc, unsigned& nx) {
    const unsigned G = gridDim.x * gridDim.y * gridDim.z;
    unsigned sum, cnt, mine, sp = 0u;
    for (;;) {
        sum = 0u; cnt = 0u; mine = 0u;
#pragma unroll
        for (unsigned j = 0; j < 16; ++j) { const unsigned c = xb_ld(&bar[XB_XCNT(j)]); sum += c; cnt += (c > 0u) ? 1u : 0u; mine = (j == x) ? c : mine; }
        if (sum == G) break;
        __builtin_amdgcn_s_sleep(1);
        if ((++sp & 255u) == 0u) { if (xb_ld(&bar[XB_TMO])) break; if (sp > XB_SPIN_CAP) { atomicAdd(&bar[XB_TMO], 1u); break; } }
    }
    nloc = mine > 0u ? mine : 1u; nx = cnt > 0u ? cnt : 1u;
}
__device__ __forceinline__ void xcd_barrier(const XcdBarrier& b) {
    asm volatile("s_waitcnt vmcnt(0)" ::: "memory");
    __syncthreads();
    if (threadIdx.x == 0) {
        unsigned* bar = b.bar;
        __builtin_amdgcn_s_waitcnt(0);
        unsigned nloc = b.st[0], nx = b.st[1];
        if (nloc == 0u) { xcd_barrier_complete(bar, b.x, nloc, nx); b.st[0] = nloc; b.st[1] = nx; }
        const unsigned old = xb_add(&bar[XB_XSUB(b.x)], 1u);
        const unsigned gen = old / nloc;
        if (old + 1u == (gen + 1u) * nloc) {
            __builtin_amdgcn_fence(__ATOMIC_RELEASE, "agent");
            asm volatile("s_waitcnt vmcnt(0)" ::: "memory");
            const unsigned og = xb_add(&bar[XB_TOP], 1u);
            const unsigned tg = og / nx;
            if (og + 1u == (tg + 1u) * nx) xb_add(&bar[XB_TOPGEN], 1u);
            else XB_SPIN(xb_ld(&bar[XB_TOPGEN]) == tg, bar);
            __builtin_amdgcn_fence(__ATOMIC_ACQUIRE, "agent");
            xb_add(&bar[XB_XGEN(b.x)], 1u);
            asm volatile("s_waitcnt vmcnt(0)" ::: "memory");
        } else {
            XB_SPIN(xb_ld(&bar[XB_XGEN(b.x)]) == gen, bar);
            __builtin_amdgcn_fence(__ATOMIC_ACQUIRE, "agent");
            asm volatile("s_waitcnt vmcnt(0)" ::: "memory");
        }
    }
    __syncthreads();
}

struct Frame {
    LAS unsigned char* lds; volatile LAS unsigned* MISC; gu32* ctl;
    int tid, lane, wave, vcu, G;
    const float* in[23]; float* out; unsigned char* ws;
};
constexpr int CW_BAR = 4096;

__device__ __forceinline__ void p0_transpose_item(const float* W, int ldw, int k0, int c0, const float* sc, bf16_t* WT, int ldt, int n0, int kd0, LAS float* scr, int lane) {
#pragma unroll 8
    for (int i = 0; i < 32; ++i) { const int kk = 2 * i + (lane >> 5); const float s = sc ? sc[k0 + kk] : 1.0f; scr[kk * 33 + (lane & 31)] = W[(size_t)(k0 + kk) * ldw + c0 + (lane & 31)] * s; }
    LDS_WAIT(); asm volatile("" ::: "memory");
    const int c = lane & 7;
#pragma unroll
    for (int j = 0; j < 4; ++j) { const int n = (lane >> 3) + 8 * j; const LAS float* s = scr + (8 * c) * 33 + n;
        u32x4 o; o.x = pk2(s[0 * 33], s[1 * 33]); o.y = pk2(s[2 * 33], s[3 * 33]); o.z = pk2(s[4 * 33], s[5 * 33]); o.w = pk2(s[6 * 33], s[7 * 33]);
        *(u32x4*)(WT + (size_t)(n0 + n) * ldt + kd0 + 8 * c) = o; }
    LDS_WAIT(); asm volatile("" ::: "memory");
}
__device__ __forceinline__ void p0_prologue(Frame& F) {
    LAS float* scr = (LAS float*)(F.lds + F.wave * 16384);
    const int gw = F.vcu * NWAVES + F.wave, NGW = F.G * NWAVES, lane = F.lane;
    const float* norm1_w = F.in[1]; const float* w_in = F.in[2]; const float* ssd_norm_w = F.in[9]; const float* w_branch = F.in[15];
    const float* w_out = F.in[16]; const float* norm2_w = F.in[17]; const float* w_up = F.in[18]; const float* w_down = F.in[21];
    bf16_t* W1t = (bf16_t*)((unsigned char*)F.out + DO_W1T); bf16_t* Bcat = (bf16_t*)(F.ws + WS_BCAT); bf16_t* Woutt = (bf16_t*)(F.ws + WS_WOUT);
    bf16_t* Wupt = (bf16_t*)(F.ws + WS_WUP); bf16_t* Wdownt = (bf16_t*)(F.ws + WS_WDOWN);
    constexpr int I_W1 = 16 * 225, I_GA = 16 * 32, I_PA = 32 * 32, I_PB = 16 * 32, I_GB = 16 * 32, I_WO = 16 * 32, I_UP = 16 * 176, I_DN = 44 * 32;
    constexpr int NITEMS = I_W1 + I_GA + I_PA + I_PB + I_GB + I_WO + I_UP + I_DN;
    for (int it = gw; it < NITEMS; it += NGW) {
        int r = it;
        if (r < I_W1) { const int kb = r / 225, nb = r % 225, n = 32 * nb; const int c = n < 5120 ? n : (n < 7168 ? n + 32 : n - 2048);
            p0_transpose_item(w_in, 9248, 64 * kb, c, norm1_w, W1t, D, n, 64 * kb, scr, lane); continue; } r -= I_W1;
        if (r < I_GA) { const int kb = r / 32, nb = r % 32; p0_transpose_item(w_in, 9248, 64 * kb, 7200 + 32 * nb, norm1_w, Bcat, BCAT_LD, 32 * nb, 64 * kb, scr, lane); continue; } r -= I_GA;
        if (r < I_PA) { const int kb = r / 32, nb = r % 32; p0_transpose_item(w_branch, D, 64 * kb, 32 * nb, ssd_norm_w, Bcat, BCAT_LD, 32 * nb, 1024 + 64 * kb, scr, lane); continue; } r -= I_PA;
        if (r < I_PB) { const int kb = r / 32, nb = r % 32; p0_transpose_item(w_branch + (size_t)DI * D, D, 64 * kb, 32 * nb, nullptr, Bcat, BCAT_LD, 32 * nb, 3072 + 64 * kb, scr, lane); continue; } r -= I_PB;
        if (r < I_GB) { const int kb = r / 32, nb = r % 32; p0_transpose_item(w_in, 9248, 64 * kb, 8224 + 32 * nb, norm1_w, Bcat, BCAT_LD, 32 * nb, 4096 + 64 * kb, scr, lane); continue; } r -= I_GB;
        if (r < I_WO) { const int kb = r / 32, nb = r % 32; p0_transpose_item(w_out, D, 64 * kb, 32 * nb, nullptr, Woutt, D, 32 * nb, 64 * kb, scr, lane); continue; } r -= I_WO;
        if (r < I_UP) { const int kb = r / 176, nb = r % 176, n = 32 * nb, j = n >> 8, w = n & 255; const int c = w < 128 ? 128 * j + w : FF + 128 * j + (w - 128);
            p0_transpose_item(w_up, 2 * FF, 64 * kb, c, norm2_w, Wupt, D, n, 64 * kb, scr, lane); continue; } r -= I_UP;
        { const int kb = r / 32, nb = r % 32; p0_transpose_item(w_down, D, 64 * kb, 32 * nb, nullptr, Wdownt, FF, 32 * nb, 64 * kb, scr, lane); }
    }
    const float* x = F.in[0]; bf16_t* ACAT = (bf16_t*)(F.ws + WS_ACAT);
    for (int m = gw; m < M; m += NGW) {
        const GAS f32x4* xr = (const GAS f32x4*)(x + (size_t)m * D) + lane;
        f32x4 v[4]; float s = 0.f;
#pragma unroll
        for (int j = 0; j < 4; ++j) { v[j] = xr[64 * j]; s += (v[j].x * v[j].x + v[j].y * v[j].y) + (v[j].z * v[j].z + v[j].w * v[j].w); }
        const float rstd = 1.f / sqrtf(wave_sum(s) * (1.f / D) + NORM_EPS);
        GAS unsigned long long* o8 = (GAS unsigned long long*)(ACAT + (size_t)m * ACAT_LD) + lane;
#pragma unroll
        for (int j = 0; j < 4; ++j) o8[64 * j] = (unsigned long long)pk2(v[j].x * rstd, v[j].y * rstd) | ((unsigned long long)pk2(v[j].z * rstd, v[j].w * rstd) << 32);
    }
}

struct SchedP1 {
    const char* A; const char* B; int G, c;
    __device__ __forceinline__ bool next(int i, Unit& u) const {
        const int L = i * G + c; if (L >= 64 * 28) return false;
        pg8::tile_of(L, 64, 28, u.pm, u.pn); u.nt = D / 64; u.kind = 0;
        u.A = A + (size_t)u.pm * 256 * ACAT_LD * 2; u.B = B + (size_t)u.pn * 256 * D * 2; return true;
    }
};
struct EpiP1 {
    static constexpr bool PERM = true;
    bf16_t* ACAT; bf16_t* XBC; bf16_t* V; bf16_t* HALO; float* VST; const float* uv_b;
    __device__ __forceinline__ void operator()(const f32x4 (&acc)[2][2][4][2], const Unit& u, int wr, int wc, int fr, int fq) const {
        const int row0 = u.pm * 256 + wr * 64 + fr, ct = u.pn * 256 + wc * 32 + 8 * fq;
        if (u.pn < 8) {
#pragma unroll
            for (int ai = 0; ai < 2; ++ai)
#pragma unroll
                for (int m = 0; m < 4; ++m) { const int r = row0 + ai * 128 + m * 16;
#pragma unroll
                    for (int bj = 0; bj < 2; ++bj) { const f32x4 v0 = acc[ai][bj][m][0], v1 = acc[ai][bj][m][1]; u32x4 w;
                        w.x = cvt_pk_bf16(fast_silu(v0[0]), fast_silu(v0[1])); w.y = cvt_pk_bf16(fast_silu(v0[2]), fast_silu(v0[3]));
                        w.z = cvt_pk_bf16(fast_silu(v1[0]), fast_silu(v1[1])); w.w = cvt_pk_bf16(fast_silu(v1[2]), fast_silu(v1[3]));
                        *(u32x4*)(ACAT + (size_t)r * ACAT_LD + 1024 + ct + bj * 128) = w; } }
        } else if (u.pn < 20) {
#pragma unroll
            for (int ai = 0; ai < 2; ++ai)
#pragma unroll
                for (int m = 0; m < 4; ++m) { const int r = row0 + ai * 128 + m * 16;
#pragma unroll
                    for (int bj = 0; bj < 2; ++bj) { const f32x4 v0 = acc[ai][bj][m][0], v1 = acc[ai][bj][m][1]; u32x4 w;
                        w.x = cvt_pk_bf16(v0[0], v0[1]); w.y = cvt_pk_bf16(v0[2], v0[3]); w.z = cvt_pk_bf16(v1[0], v1[1]); w.w = cvt_pk_bf16(v1[2], v1[3]);
                        const int c = ct + bj * 128 - 2048;
                        *(u32x4*)(XBC + (size_t)r * XBCW + c) = w;
                        if ((r & 127) >= 125) *(u32x4*)(HALO + (size_t)((r >> 7) * 3 + (r & 127) - 125) * XBCW + c) = w; } }
        } else {
            const bool isv = u.pn >= 24;
#pragma unroll
            for (int ai = 0; ai < 2; ++ai)
#pragma unroll
                for (int m = 0; m < 4; ++m) { const int r = row0 + ai * 128 + m * 16; float s = 0.f, q = 0.f;
#pragma unroll
                    for (int bj = 0; bj < 2; ++bj) { const int c = ct + bj * 128 - 5120;
                        const f32x4 b0 = *(const f32x4*)(uv_b + c), b1 = *(const f32x4*)(uv_b + c + 4);
                        f32x4 v0 = acc[ai][bj][m][0] + b0, v1 = acc[ai][bj][m][1] + b1;
#pragma unroll
                        for (int i = 0; i < 4; ++i) { v0[i] = gelu_tanh(v0[i]); v1[i] = gelu_tanh(v1[i]); s += v0[i] + v1[i]; q += v0[i] * v0[i] + v1[i] * v1[i]; }
                        u32x4 w; w.x = cvt_pk_bf16(v0[0], v0[1]); w.y = cvt_pk_bf16(v0[2], v0[3]); w.z = cvt_pk_bf16(v1[0], v1[1]); w.w = cvt_pk_bf16(v1[2], v1[3]);
                        if (!isv) *(u32x4*)(ACAT + (size_t)r * ACAT_LD + 3072 + c) = w; else *(u32x4*)(V + (size_t)r * D + (c - 1024)) = w; }
                    if (isv) { s += __shfl_xor(s, 16); s += __shfl_xor(s, 32); q += __shfl_xor(q, 16); q += __shfl_xor(q, 32);
                        if (fq == 0) *(f32x2*)(VST + ((size_t)r * 16 + (u.pn - 24) * 4 + wc) * 2) = (f32x2){s, q}; } }
        }
    }
};
__device__ __forceinline__ void p1_dt(Frame& F) {
    const bf16_t* XN = (const bf16_t*)(F.ws + WS_ACAT); const bf16_t* Wdt = (const bf16_t*)((unsigned char*)F.out + DO_W1T) + (size_t)N1 * D;
    float* DT = (float*)((unsigned char*)F.out + DO_DT); const float* dt_bias = F.in[6];
    const int gw = F.vcu * NWAVES + F.wave, NGW = F.G * NWAVES, fr = F.lane & 15, fq = F.lane >> 4;
    for (int item = gw; item < 2048; item += NGW) { const int rb = item >> 1, nb = item & 1;
        f32x4 acc = (f32x4){0.f, 0.f, 0.f, 0.f};
        const bf16_t* ap = XN + (size_t)(rb * 16 + fr) * ACAT_LD + fq * 8; const bf16_t* bp = Wdt + (size_t)(nb * 16 + fr) * D + fq * 8;
#pragma unroll 4
        for (int ks = 0; ks < 32; ++ks) { const bf16x8 a = *(const bf16x8*)(ap + ks * 32), b = *(const bf16x8*)(bp + ks * 32); acc = __builtin_amdgcn_mfma_f32_16x16x32_bf16(a, b, acc, 0, 0, 0); }
        const float bias = dt_bias[nb * 16 + fr];
#pragma unroll
        for (int j = 0; j < 4; ++j) { const float v = acc[j] + bias; const float sp = fmaxf(v, 0.f) + log1pf(expf(-fabsf(v))); DT[(size_t)(rb * 16 + 4 * fq + j) * NH + nb * 16 + fr] = sp; }
    }
}

struct SchedP3 {
    const char* A; const char* B; int pm, pn;
    __device__ __forceinline__ bool next(int i, Unit& u) const {
        if (i >= 4) return false;
        u.pm = pm; u.pn = pn; u.kind = i;
        const int acol = (i == 1) ? 1024 : (i == 3 ? 3072 : 0), bcol = (i == 0) ? 0 : (i == 1 ? 1024 : (i == 2 ? 4096 : 3072));
        u.nt = (i == 1) ? 32 : 16;
        u.A = A + ((size_t)pm * 256 * ACAT_LD + acol) * 2; u.B = B + ((size_t)pn * 256 * BCAT_LD + bcol) * 2; return true;
    }
};
struct EpiP3 {
    static constexpr bool PERM = true;
    bf16_t* G; bf16_t* T; const float* b_gate; const float* SSQ;
    __device__ __forceinline__ void operator()(const f32x4 (&acc)[2][2][4][2], const Unit& u, int wr, int wc, int fr, int fq) const {
        const int row0 = u.pm * 256 + wr * 64 + fr, ct = u.pn * 256 + wc * 32 + 8 * fq;
        if (u.kind == 0 || u.kind == 2) {
            const float* bg = b_gate + (u.kind == 2 ? 1024 : 0);
#pragma unroll
            for (int bj = 0; bj < 2; ++bj) { const int c = ct + bj * 128; const f32x4 b0 = *(const f32x4*)(bg + c), b1 = *(const f32x4*)(bg + c + 4);
#pragma unroll
                for (int ai = 0; ai < 2; ++ai)
#pragma unroll
                    for (int m = 0; m < 4; ++m) { const int r = row0 + ai * 128 + m * 16; const f32x4 v0 = acc[ai][bj][m][0] + b0, v1 = acc[ai][bj][m][1] + b1; u32x4 w;
                        w.x = cvt_pk_bf16(fast_sigmoid(v0[0]), fast_sigmoid(v0[1])); w.y = cvt_pk_bf16(fast_sigmoid(v0[2]), fast_sigmoid(v0[3]));
                        w.z = cvt_pk_bf16(fast_sigmoid(v1[0]), fast_sigmoid(v1[1])); w.w = cvt_pk_bf16(fast_sigmoid(v1[2]), fast_sigmoid(v1[3]));
                        *(u32x4*)(G + (size_t)r * D + c) = w; } }
        } else if (u.kind == 1) {
#pragma unroll
            for (int ai = 0; ai < 2; ++ai)
#pragma unroll
                for (int m = 0; m < 4; ++m) { const int r = row0 + ai * 128 + m * 16;
                    float ss = 0.f;
#pragma unroll
                    for (int j = 0; j < 4; ++j) { const f32x4 p = *(const f32x4*)(SSQ + (size_t)r * 64 + fq * 16 + j * 4); ss += (p[0] + p[1]) + (p[2] + p[3]); }
                    ss += __shfl_xor(ss, 16); ss += __shfl_xor(ss, 32);
                    const float rs = 1.0f / sqrtf(ss * (1.0f / DI) + NORM_EPS);
#pragma unroll
                    for (int bj = 0; bj < 2; ++bj) { const int c = ct + bj * 128; const u32x4 g = *(const u32x4*)(G + (size_t)r * D + c); const f32x4 v0 = acc[ai][bj][m][0] * rs, v1 = acc[ai][bj][m][1] * rs; u32x4 w;
                        w.x = cvt_pk_bf16(bf_lo(g.x) * v0[0], bf_hi(g.x) * v0[1]); w.y = cvt_pk_bf16(bf_lo(g.y) * v0[2], bf_hi(g.y) * v0[3]);
                        w.z = cvt_pk_bf16(bf_lo(g.z) * v1[0], bf_hi(g.z) * v1[1]); w.w = cvt_pk_bf16(bf_lo(g.w) * v1[2], bf_hi(g.w) * v1[3]);
                        *(u32x4*)(T + (size_t)r * D + c) = w; } }
        } else {
#pragma unroll
            for (int ai = 0; ai < 2; ++ai)
#pragma unroll
                for (int m = 0; m < 4; ++m) { const int r = row0 + ai * 128 + m * 16;
#pragma unroll
                    for (int bj = 0; bj < 2; ++bj) { const int c = ct + bj * 128; const u32x4 g = *(const u32x4*)(G + (size_t)r * D + c); const u32x4 t = *(const u32x4*)(T + (size_t)r * D + c);
                        const f32x4 v0 = acc[ai][bj][m][0], v1 = acc[ai][bj][m][1]; u32x4 w;
                        w.x = cvt_pk_bf16(bf_lo(t.x) + bf_lo(g.x) * v0[0], bf_hi(t.x) + bf_hi(g.x) * v0[1]); w.y = cvt_pk_bf16(bf_lo(t.y) + bf_lo(g.y) * v0[2], bf_hi(t.y) + bf_hi(g.y) * v0[3]);
                        w.z = cvt_pk_bf16(bf_lo(t.z) + bf_lo(g.z) * v1[0], bf_hi(t.z) + bf_hi(g.z) * v1[1]); w.w = cvt_pk_bf16(bf_lo(t.w) + bf_lo(g.w) * v1[2], bf_hi(t.w) + bf_hi(g.w) * v1[3]);
                        *(u32x4*)(T + (size_t)r * D + c) = w; } }
        }
    }
};

struct SchedSq {
    const char* A; const char* B; int lda, K, c;
    __device__ __forceinline__ bool next(int i, Unit& u) const {
        if (i >= 1 || c >= 256) return false;
        pg8::tile_of(c, 64, 4, u.pm, u.pn); u.nt = K / 64; u.kind = 0;
        u.A = A + (size_t)u.pm * 256 * lda * 2; u.B = B + (size_t)u.pn * 256 * K * 2; return true;
    }
};
template <bool WRITE_BF16> struct EpiRes {
    static constexpr bool PERM = false;
    const float* base; float* out; bf16_t* ob; float* SS;
    __device__ __forceinline__ void operator()(const f32x4 (&acc)[2][2][4][2], const Unit& u, int wr, int wc, int fr, int fq) const {
        const int row0 = u.pm * 256 + wr * 64 + fr, col0 = u.pn * 256 + wc * 32 + 4 * fq;
#pragma unroll
        for (int ai = 0; ai < 2; ++ai)
#pragma unroll
            for (int m = 0; m < 4; ++m) { const int r = row0 + ai * 128 + m * 16; const size_t off = (size_t)r * D + col0; float q = 0.f;
#pragma unroll
                for (int bj = 0; bj < 2; ++bj)
#pragma unroll
                    for (int n = 0; n < 2; ++n) { const size_t o = off + bj * 128 + n * 16; const f32x4 h = *(const f32x4*)(base + o) + acc[ai][bj][m][n];
                        *(f32x4*)(out + o) = h; q += (h[0] * h[0] + h[1] * h[1]) + (h[2] * h[2] + h[3] * h[3]);
                        if (WRITE_BF16) { u32x2 w; w.x = cvt_pk_bf16(h[0], h[1]); w.y = cvt_pk_bf16(h[2], h[3]); *(u32x2*)(ob + o) = w; } }
                q += __shfl_xor(q, 16); q += __shfl_xor(q, 32);
                if (fq == 0) SS[(size_t)r * 16 + u.pn * 4 + wc] = q; }
    }
};

struct SchedP5 {
    const char* A; const char* B; int G, c;
    __device__ __forceinline__ bool next(int i, Unit& u) const {
        const int L = i * G + c; if (L >= 68 * 22) return false;
        pg8::tile_of(L, 68, 22, u.pm, u.pn); u.nt = D / 64;
        const int q = u.pm / 17, ii = u.pm % 17, o = ii < 16 ? 248 * ii : SEQ - 248;
        u.kind = q * SEQ + o;
        u.A = A + ((long)u.kind - 2) * (long)(D * 2); u.B = B + (size_t)u.pn * 256 * D * 2; return true;
    }
};
template <int CTRL> __device__ __forceinline__ float dpp_keep(float oldv, float x) { return __builtin_bit_cast(float, __builtin_amdgcn_update_dpp(__builtin_bit_cast(int, oldv), __builtin_bit_cast(int, x), CTRL, 0xf, 0xf, false)); }
struct EpiP5 {
    static constexpr bool PERM = true;
    bf16_t* ACT; const float* SS2; const float* cw; const float* cb;
    __device__ __forceinline__ void operator()(f32x4 (&acc)[2][2][4][2], const Unit& u, int wr, int wc, int fr, int fq) const {
        const int tok0 = u.kind, ii = u.pm % 17; const int skip = ii < 16 ? 0 : 120; const bool first = (ii == 0);
        const int j0 = u.pn * 128 + wc * 32 + 8 * fq;
#pragma unroll
        for (int ai = 0; ai < 2; ++ai)
#pragma unroll
            for (int m = 0; m < 4; ++m) { const int blk = 2 * ai + wr, lr = 16 * m + fr; const int tok = tok0 + 62 * blk + lr - 2;
                const bool zero = first && blk == 0 && lr < 2;
                const int tokc = zero ? tok0 : tok;
                const f32x4 p = *(const f32x4*)(SS2 + (size_t)tokc * 16 + 4 * fq); float ss = (p[0] + p[1]) + (p[2] + p[3]);
                ss += __shfl_xor(ss, 16); ss += __shfl_xor(ss, 32);
                const float rs = 1.0f / sqrtf(ss * (1.0f / D) + NORM_EPS);
#pragma unroll
                for (int bj = 0; bj < 2; ++bj)
#pragma unroll
                    for (int n = 0; n < 2; ++n) acc[ai][bj][m][n] = zero ? (f32x4){0.f, 0.f, 0.f, 0.f} : acc[ai][bj][m][n] * rs; }
#pragma unroll
        for (int n = 0; n < 2; ++n) {
            f32x4 w0[2], w1[2], w2[2], bb[2];
#pragma unroll
            for (int bj = 0; bj < 2; ++bj) { const int ch = bj * FF + j0 + 4 * n; w0[bj] = *(const f32x4*)(cw + ch); w1[bj] = *(const f32x4*)(cw + 2 * FF + ch); w2[bj] = *(const f32x4*)(cw + 4 * FF + ch); bb[bj] = *(const f32x4*)(cb + ch); }
#pragma unroll
            for (int ai = 0; ai < 2; ++ai) { const int blk = 2 * ai + wr;
#pragma unroll
                for (int m = 3; m >= 0; --m) {
                    f32x4 cv[2];
#pragma unroll
                    for (int bj = 0; bj < 2; ++bj) {
#pragma unroll
                        for (int i = 0; i < 4; ++i) { const float x = acc[ai][bj][m][n][i]; const float xp = m > 0 ? acc[ai][bj][m - 1][n][i] : 0.f;
                            const float s1 = dpp_keep<0x111>(dpp_keep<0x121>(0.f, xp), x);
                            const float s2 = dpp_keep<0x112>(dpp_keep<0x122>(0.f, xp), x);
                            cv[bj][i] = bb[bj][i] + w2[bj][i] * x + w1[bj][i] * s1 + w0[bj][i] * s2; } }
                    const int lr = 16 * m + fr, oi = 62 * blk + lr - 2;
                    u32x2 w; w.x = cvt_pk_bf16(fast_silu(cv[0][0]) * cv[1][0], fast_silu(cv[0][1]) * cv[1][1]); w.y = cvt_pk_bf16(fast_silu(cv[0][2]) * cv[1][2], fast_silu(cv[0][3]) * cv[1][3]);
                    if (lr >= 2 && oi >= skip) *(u32x2*)(ACT + (size_t)(tok0 + oi) * FF + j0 + 4 * n) = w;
                    asm volatile("" ::: "memory");
                }
            }
        }
    }
};

__device__ __forceinline__ void p7_final(Frame& F) {
    const float* SS3 = (const float*)(F.ws + WS_SS3); const float* fw = F.in[22];
    const int gw = F.vcu * NWAVES + F.wave, NGW = F.G * NWAVES, lane = F.lane;
    f32x4 wv[4];
#pragma unroll
    for (int j = 0; j < 4; ++j) wv[j] = *((const f32x4*)fw + lane + 64 * j);
    for (int m = gw; m < M; m += NGW) {
        float ss = lane < 16 ? SS3[(size_t)m * 16 + lane] : 0.f; ss = wave_sum(ss);
        const float rs = 1.0f / sqrtf(ss * (1.0f / D) + NORM_EPS);
        GAS f32x4* o = (GAS f32x4*)(F.out + (size_t)m * D) + lane;
#pragma unroll
        for (int j = 0; j < 4; ++j) { f32x4 v = o[64 * j]; v = v * rs * wv[j]; o[64 * j] = v; }
    }
}

struct Args { const float* in[23]; float* out; unsigned char* ws; int ph_lo, ph_hi, li, pad; };
__global__ void __launch_bounds__(NWAVES * 64, 2) mk_fwd(Args args) {
    extern __shared__ __attribute__((aligned(16))) unsigned char lds[];
    Frame F;
    F.lds = (LAS unsigned char*)lds; F.MISC = (volatile LAS unsigned*)(F.lds + MISC_OFF);
    F.tid = threadIdx.x; F.lane = F.tid & 63; F.wave = __builtin_amdgcn_readfirstlane(F.tid >> 6);
    F.G = gridDim.x; { const int bx = blockIdx.x; F.vcu = (F.G % 8 == 0) ? (bx % 8) * (F.G / 8) + bx / 8 : bx; }
#pragma unroll
    for (int i = 0; i < 23; ++i) F.in[i] = args.in[i];
    F.out = args.out; F.ws = args.ws; F.ctl = (gu32*)(args.ws + WS_CTL);
    for (int u = F.tid; u < (LDS_BYTES - LDSCTL_OFF) / 4; u += NWAVES * 64) ((LAS unsigned*)(F.lds + LDSCTL_OFF))[u] = 0u;
    __syncthreads();
    XcdBarrier bar; bar.bar = (unsigned*)(F.ctl + CW_BAR); bar.x = 0; bar.st = nullptr;
    if (MK_N_LAUNCHES == 1) bar = xcd_barrier_post((unsigned*)(F.ctl + CW_BAR), F.MISC + 8);
#define GRID_BAR() do { if (MK_N_LAUNCHES == 1) xcd_barrier(bar); } while (0)
    const int lo = args.ph_lo, hi = args.ph_hi;
#ifndef PH_MASK
#define PH_MASK 0xff
#endif
#define IN(k) (((PH_MASK >> (k)) & 1) && lo <= (k) && (k) < hi)
    unsigned char* dout = (unsigned char*)F.out;

    if (IN(0)) { p0_prologue(F); GRID_BAR(); }
    if (IN(1)) {
        SchedP1 S{(const char*)(F.ws + WS_ACAT), (const char*)(dout + DO_W1T), F.G, (int)blockIdx.x};
        EpiP1 E{(bf16_t*)(F.ws + WS_ACAT), (bf16_t*)(F.ws + WS_XBC), (bf16_t*)(dout + DO_V), (bf16_t*)(dout + DO_HALO), (float*)(dout + DO_VST), F.in[10]};
        pg8::gemm_phase<EpiP1, SchedP1, true, false>(F.lds, ACAT_LD, D, S, E);
        p1_dt(F);
        GRID_BAR();
    }
    if (IN(3)) {
        int pm, pn; pg8::tile_of((int)blockIdx.x, 64, 4, pm, pn);
        SchedP3 S{(const char*)(F.ws + WS_ACAT), (const char*)(F.ws + WS_BCAT), pm, pn};
        EpiP3 E{(bf16_t*)(F.ws + WS_G), (bf16_t*)(F.ws + WS_T), F.in[3], (const float*)(dout + DO_SSQ)};
        if (blockIdx.x < 256) pg8::gemm_phase<EpiP3, SchedP3, true, false>(F.lds, ACAT_LD, BCAT_LD, S, E);
        GRID_BAR();
    }
    if (IN(4)) {
        SchedSq S{(const char*)(F.ws + WS_T), (const char*)(F.ws + WS_WOUT), D, D, (int)blockIdx.x};
        EpiRes<true> E{F.in[0], (float*)(F.ws + WS_H), (bf16_t*)(F.ws + WS_HB), (float*)(F.ws + WS_SS2)};
        pg8::gemm_phase<EpiRes<true>, SchedSq, true, false>(F.lds, D, D, S, E);
        GRID_BAR();
    }
    if (IN(5)) {
        SchedP5 S{(const char*)(F.ws + WS_HB), (const char*)(F.ws + WS_WUP), F.G, (int)blockIdx.x};
        EpiP5 E{(bf16_t*)(F.ws + WS_ACT), (const float*)(F.ws + WS_SS2), F.in[19], F.in[20]};
        pg8::gemm_phase<EpiP5, SchedP5, true, true>(F.lds, D, D, S, E);
        GRID_BAR();
    }
    if (IN(6)) {
        SchedSq S{(const char*)(F.ws + WS_ACT), (const char*)(F.ws + WS_WDOWN), FF, FF, (int)blockIdx.x};
        EpiRes<false> E{(const float*)(F.ws + WS_H), F.out, nullptr, (float*)(F.ws + WS_SS3)};
        pg8::gemm_phase<EpiRes<false>, SchedSq, true, false>(F.lds, FF, FF, S, E);
        GRID_BAR();
    }
    if (IN(7)) p7_final(F);
#undef IN
#undef GRID_BAR
}

__global__ void __launch_bounds__(64) ssd_naive(const bf16_t* XBC, const float* DT, bf16_t* ACAT, float* SSQ,
                                               const float* conv_w, const float* conv_b, const float* a_log, const float* d_skip) {
    __shared__ float sB[2][NS], sC[2][NS];
    const int b = blockIdx.x >> 5, h = blockIdx.x & 31, g = h >> 3, p = threadIdx.x;
    const float a = -expf(a_log[h]), dsk = d_skip[h];
    const int chx = h * HD + p;
    int ch[4]; ch[0] = DI + g * NS + p; ch[1] = ch[0] + 64; ch[2] = DI + NG * NS + g * NS + p; ch[3] = ch[2] + 64;
    float wx[4], wq[4][4]; const float bx = conv_b[chx]; float bq[4];
#pragma unroll
    for (int k = 0; k < 4; ++k) wx[k] = conv_w[k * XBCW + chx];
#pragma unroll
    for (int j = 0; j < 4; ++j) { bq[j] = conv_b[ch[j]];
#pragma unroll
        for (int k = 0; k < 4; ++k) wq[j][k] = conv_w[k * XBCW + ch[j]]; }
    float hs[NS];
#pragma unroll
    for (int n = 0; n < NS; ++n) hs[n] = 0.f;
    float xh[3] = {0.f, 0.f, 0.f}, qh[4][3];
#pragma unroll
    for (int j = 0; j < 4; ++j) { qh[j][0] = 0.f; qh[j][1] = 0.f; qh[j][2] = 0.f; }
    size_t row = (size_t)b * SEQ;
    bf16_t nx = XBC[row * XBCW + chx], nq[4];
#pragma unroll
    for (int j = 0; j < 4; ++j) nq[j] = XBC[row * XBCW + ch[j]];
    float ndt = DT[row * NH + h]; bf16_t nz = ACAT[row * ACAT_LD + 1024 + chx];
    for (int t = 0; t < SEQ; ++t) {
        row = (size_t)b * SEQ + t;
        const float xc = bf2f(nx); float qc[4];
#pragma unroll
        for (int j = 0; j < 4; ++j) qc[j] = bf2f(nq[j]);
        const float dt = ndt; const float zs = bf2f(nz);
        if (t + 1 < SEQ) { const size_t r1 = row + 1; nx = XBC[r1 * XBCW + chx];
#pragma unroll
            for (int j = 0; j < 4; ++j) nq[j] = XBC[r1 * XBCW + ch[j]];
            ndt = DT[r1 * NH + h]; nz = ACAT[r1 * ACAT_LD + 1024 + chx]; }
        const float xv = fast_silu(bx + wx[0] * xh[0] + wx[1] * xh[1] + wx[2] * xh[2] + wx[3] * xc);
        xh[0] = xh[1]; xh[1] = xh[2]; xh[2] = xc;
        const int buf = t & 1;
#pragma unroll
        for (int j = 0; j < 4; ++j) { const float v = fast_silu(bq[j] + wq[j][0] * qh[j][0] + wq[j][1] * qh[j][1] + wq[j][2] * qh[j][2] + wq[j][3] * qc[j]);
            qh[j][0] = qh[j][1]; qh[j][1] = qh[j][2]; qh[j][2] = qc[j];
            if (j < 2) sB[buf][p + 64 * j] = v; else sC[buf][p + 64 * (j - 2)] = v; }
        __syncthreads();
        const float dA = expf(dt * a), xdt = xv * dt; float y = 0.f;
#pragma unroll
        for (int n = 0; n < NS; n += 4) { const f32x4 Bv = *(const f32x4*)&sB[buf][n], Cv = *(const f32x4*)&sC[buf][n];
#pragma unroll
            for (int i = 0; i < 4; ++i) { hs[n + i] = hs[n + i] * dA + xdt * Bv[i]; y += Cv[i] * hs[n + i]; } }
        y += dsk * xv;
        const float yz = y * zs;
        ACAT[row * ACAT_LD + 1024 + chx] = (bf16_t)f2bf(yz);
        const float ssq = wave_sum(yz * yz);
        if (p == 0) { SSQ[row * 64 + 2 * h] = ssq; SSQ[row * 64 + 2 * h + 1] = 0.f; }
    }
}
__global__ void __launch_bounds__(64) sgu_naive(const bf16_t* V, const float* VST, bf16_t* ACAT, const float* ln_w, const float* ln_b, const float* w_sp, const float* b_sp) {
    __shared__ float sv[CHUNK][64];
    __shared__ float smean[CHUNK], srstd[CHUNK];
    const int bc = blockIdx.x >> 4, g = (blockIdx.x >> 1) & 7, d = (blockIdx.x & 1) * 64 + threadIdx.x; const size_t row0 = (size_t)bc * CHUNK;
    for (int s = threadIdx.x; s < CHUNK; s += 64) { float su = 0.f, sq = 0.f;
        for (int j = 0; j < 16; ++j) { su += VST[((row0 + s) * 16 + j) * 2]; sq += VST[((row0 + s) * 16 + j) * 2 + 1]; }
        const float mu = su * (1.0f / D); const float var = fmaxf(sq * (1.0f / D) - mu * mu, 0.f); smean[s] = mu; srstd[s] = 1.0f / sqrtf(var + LN_EPS); }
    __syncthreads();
    const float lw = ln_w[g * NS + d], lb = ln_b[g * NS + d];
    for (int s = 0; s < CHUNK; ++s) sv[s][threadIdx.x] = (bf2f(V[(row0 + s) * D + g * NS + d]) - smean[s]) * srstd[s] * lw + lb;
    __syncthreads();
    for (int t = 0; t < CHUNK; ++t) { const float* wr = w_sp + ((size_t)g * CHUNK + t) * CHUNK; float mix = b_sp[g * CHUNK + t];
        for (int s = 0; s <= t; ++s) mix += wr[s] * sv[s][threadIdx.x];
        bf16_t* up = ACAT + (row0 + t) * ACAT_LD + 3072 + g * NS + d;
        *up = (bf16_t)f2bf(bf2f(*up) * mix); }
}

#ifndef DBG_STOP
#define DBG_STOP 0
#endif
#if DBG_STOP
__global__ void dbg_digest(const unsigned char* dout, float* dig, int which) {
    const int row = blockIdx.x * blockDim.x + threadIdx.x; if (row >= M) return; float s = 0.f;
    if (which == 1) { const bf16_t* V = (const bf16_t*)(dout + DO_V); const float* DT = (const float*)(dout + DO_DT); const float* VST = (const float*)(dout + DO_VST);
        for (int c = 0; c < D; ++c) s += bf2f(V[(size_t)row * D + c]); for (int c = 0; c < NH; ++c) s += DT[(size_t)row * NH + c]; for (int c = 0; c < 32; ++c) s += 1e-3f * VST[(size_t)row * 32 + c]; }
    else { const float* SSQ = (const float*)(dout + DO_SSQ); for (int c = 0; c < 64; ++c) s += SSQ[(size_t)row * 64 + c]; }
    dig[row] = s;
}
__global__ void dbg_dump(const unsigned char* ws, float* out, const float* dig, int which) {
    const size_t i = (size_t)blockIdx.x * blockDim.x + threadIdx.x; if (i >= (size_t)M * D) return; const size_t row = i / D; const int c = (int)(i % D); float v = 0.f;
    const bf16_t* XBC = (const bf16_t*)(ws + WS_XBC); const bf16_t* ACAT = (const bf16_t*)(ws + WS_ACAT);
    if (which == 1) { v = bf2f(XBC[row * XBCW + c]) + bf2f(XBC[row * XBCW + 1024 + c]) + bf2f(XBC[row * XBCW + 2048 + c]) + bf2f(ACAT[row * ACAT_LD + c]) + bf2f(ACAT[row * ACAT_LD + 1024 + c]) + bf2f(ACAT[row * ACAT_LD + 2048 + c]) + bf2f(ACAT[row * ACAT_LD + 3072 + c]) + dig[row]; }
    else if (which == 2) { v = bf2f(ACAT[row * ACAT_LD + 1024 + c]) + bf2f(ACAT[row * ACAT_LD + 2048 + c]) + bf2f(ACAT[row * ACAT_LD + 3072 + c]) + 1e-3f * dig[row]; }
    else if (which == 3) { v = bf2f(((const bf16_t*)(ws + WS_T))[i]); }
    else if (which == 4) { v = ((const float*)(ws + WS_H))[i] + bf2f(((const bf16_t*)(ws + WS_HB))[i]); }
    else if (which == 5) { const bf16_t* A = (const bf16_t*)(ws + WS_ACT); v = bf2f(A[row * FF + c]) + bf2f(A[row * FF + 1024 + c]) + bf2f(A[row * FF + 1792 + c]); }
    out[i] = v;
}
#endif

extern "C" void kernel_launch(void* const* d_in, const int* in_sizes, int n_in, void* d_out, int out_size, void* d_ws, size_t ws_size, hipStream_t stream) {
    static int grid = 0;
    if (grid == 0) {
        if (n_in != 23 || in_sizes[0] != M * D || out_size != M * D || ws_size < WS_END) { fprintf(stderr, "kernel_launch: unexpected shapes (n_in %d, in0 %d, out %d, ws %zu)\n", n_in, n_in > 0 ? in_sizes[0] : -1, out_size, ws_size); grid = -1; return; }
        int dev = 0, cus = 0, per_cu = 0;
        if (hipGetDevice(&dev) != hipSuccess || hipDeviceGetAttribute(&cus, hipDeviceAttributeMultiprocessorCount, dev) != hipSuccess) { grid = -1; return; }
        if (hipFuncSetAttribute((const void*)mk_fwd, hipFuncAttributeMaxDynamicSharedMemorySize, LDS_BYTES) != hipSuccess) { fprintf(stderr, "kernel_launch: hipFuncSetAttribute failed\n"); grid = -1; return; }
        if (hipOccupancyMaxActiveBlocksPerMultiprocessor(&per_cu, (const void*)mk_fwd, NWAVES * 64, LDS_BYTES) != hipSuccess || per_cu < 1) { fprintf(stderr, "kernel_launch: occupancy query says %d blocks per CU\n", per_cu); (void)hipGetLastError(); grid = -1; return; }
        grid = cus;
        if (grid != 256) fprintf(stderr, "kernel_launch: %d CUs (built for 256)\n", grid);
    }
    if (grid < 0) return;
    (void)hipMemsetAsync((char*)d_ws + WS_CTL, 0, CTL_ZERO_BYTES, stream);
    Args a{};
    for (int i = 0; i < 23; ++i) a.in[i] = (const float*)d_in[i];
    a.out = (float*)d_out; a.ws = (unsigned char*)d_ws;
    unsigned char* dout = (unsigned char*)d_out; unsigned char* ws = (unsigned char*)d_ws;
#if MK_N_LAUNCHES == 1
    a.ph_lo = 0; a.ph_hi = 8; a.li = 0;
    hipLaunchKernelGGL(mk_fwd, dim3(grid), dim3(NWAVES * 64), LDS_BYTES, stream, a);
#else
    for (int ph = 0; ph < 8; ++ph) {
        if (ph == 2) {
            hipLaunchKernelGGL(ssd_naive, dim3(BATCH * NH), dim3(64), 0, stream, (const bf16_t*)(ws + WS_XBC), (const float*)(dout + DO_DT), (bf16_t*)(ws + WS_ACAT), (float*)(dout + DO_SSQ),
                               (const float*)d_in[4], (const float*)d_in[5], (const float*)d_in[7], (const float*)d_in[8]);
            hipLaunchKernelGGL(sgu_naive, dim3(M / CHUNK * 16), dim3(64), 0, stream, (const bf16_t*)(dout + DO_V), (const float*)(dout + DO_VST), (bf16_t*)(ws + WS_ACAT),
                               (const float*)d_in[11], (const float*)d_in[12], (const float*)d_in[13], (const float*)d_in[14]);
#if DBG_STOP == 2
            { float* dig = (float*)(ws + WS_SS2); hipLaunchKernelGGL(dbg_digest, dim3(M / 256), dim3(256), 0, stream, (const unsigned char*)dout, dig, 2);
              hipLaunchKernelGGL(dbg_dump, dim3(M * D / 256), dim3(256), 0, stream, (const unsigned char*)ws, (float*)d_out, (const float*)dig, 2); break; }
#endif
            continue;
        }
        a.ph_lo = ph; a.ph_hi = ph + 1; a.li = ph;
        hipLaunchKernelGGL(mk_fwd, dim3(grid), dim3(NWAVES * 64), LDS_BYTES, stream, a);
#if DBG_STOP
        if (ph == DBG_STOP && DBG_STOP != 2) { float* dig = (float*)(ws + WS_SS2);
            if (DBG_STOP == 1) hipLaunchKernelGGL(dbg_digest, dim3(M / 256), dim3(256), 0, stream, (const unsigned char*)dout, dig, 1);
            hipLaunchKernelGGL(dbg_dump, dim3(M * D / 256), dim3(256), 0, stream, (const unsigned char*)ws, (float*)d_out, (const float*)dig, DBG_STOP); break; }
#endif
    }
#endif
}
```

```cpp
#include <hip/hip_runtime.h>
#include <cstdio>
#include <cstdint>

#ifndef MK_N_LAUNCHES
#define MK_N_LAUNCHES 1
#endif

constexpr int D = 1024, SEQ = 4096, BATCH = 4, M = BATCH * SEQ;
constexpr int DI = 2048, NH = 32, HD = 64, NG = 4, NS = 128, XBCW = 3072, CHUNK = 128;
constexpr int N1 = 7168;
constexpr int FF = 2816;
constexpr int ACAT_LD = 4096;
constexpr int BCAT_LD = 5120;
constexpr float NORM_EPS = 1e-6f, LN_EPS = 1e-5f;

constexpr size_t MiB = 1u << 20;
constexpr size_t WS_CTL = 0, CTL_ZERO_BYTES = 64 * 1024;
constexpr size_t WS_BCAT = 1 * MiB, WS_WOUT = 11 * MiB, WS_WUP = 13 * MiB, WS_WDOWN = 24 * MiB;
constexpr size_t WS_SS2 = 29 * MiB + 512 * 1024, WS_SS3 = 30 * MiB + 512 * 1024;
constexpr size_t WS_ACAT = 32 * MiB, WS_XBC = 160 * MiB, WS_END = 256 * MiB;
constexpr size_t WS_T = 160 * MiB, WS_G = 192 * MiB, WS_H = 192 * MiB, WS_HB = 32 * MiB, WS_ACT = 64 * MiB;
constexpr size_t DO_V = 0, DO_W1T = 32 * MiB, DO_DT = 48 * MiB, DO_ACUM = 50 * MiB, DO_SSQ = 52 * MiB, DO_HALO = 56 * MiB, DO_VST = 59 * MiB;

namespace pg8 {
#define PG8_LAS __attribute__((address_space(3)))
typedef unsigned short bf16_t;
typedef short bf16x8 __attribute__((ext_vector_type(8)));
typedef float f32x4 __attribute__((ext_vector_type(4)));
typedef float f32x2 __attribute__((ext_vector_type(2)));
typedef unsigned u32x4 __attribute__((ext_vector_type(4)));
typedef unsigned u32x2 __attribute__((ext_vector_type(2)));
constexpr int BM = 256, BK = 64, HALF = 128, HTB = HALF * BK * 2, STAGE_BYTES = 8 * HTB, NXCD = 8, WGM = 8;

__host__ __device__ __forceinline__ int lds_byte(int r, int c) { const int st = (r >> 4) * 2 + (c >> 5), rr = r & 15, cc = c & 31, ob = rr * 64 + cc * 2; return st * 1024 + (ob ^ (((ob >> 9) & 1) << 5)); }
__host__ __device__ __forceinline__ void stage_rc(int b, int& R, int& C) { const int st = b / 1024, sb = b % 1024, swz = sb ^ (((sb >> 9) & 1) << 5); R = (st >> 1) * 16 + swz / 64; C = (st & 1) * 32 + (swz % 64) / 2; }
__host__ __device__ __forceinline__ int perm32(int rho) { const int n = rho >> 4, i = rho & 15; return 8 * (i >> 2) + 4 * n + (i & 3); }

struct Unit { const char* A; const char* B; int nt, pm, pn, kind; };

__device__ __forceinline__ void tile_of(int L, int nM, int nN, int& pm, int& pn) {
    const int nwg = nM * nN; int wgid = L; { const int q = nwg / NXCD, r = nwg % NXCD, xcd = wgid % NXCD, off = wgid / NXCD; wgid = (xcd < r ? xcd * (q + 1) : r * (q + 1) + (xcd - r) * q) + off; }
    const int nig = WGM * nN, gid = wgid / nig, fm = gid * WGM, gsz = (nM - fm) < WGM ? (nM - fm) : WGM;
    pm = fm + ((wgid % nig) % gsz); pn = (wgid % nig) / gsz;
}

typedef __bf16 bf16x2_t __attribute__((ext_vector_type(2)));
__device__ __forceinline__ unsigned cvt_pk_bf16(float lo, float hi) { const f32x2 v = {lo, hi}; return __builtin_bit_cast(unsigned, __builtin_convertvector(v, bf16x2_t)); }
__device__ __forceinline__ float bf_lo(unsigned w) { return __builtin_bit_cast(float, w << 16); }
__device__ __forceinline__ float bf_hi(unsigned w) { return __builtin_bit_cast(float, w & 0xffff0000u); }
__device__ __forceinline__ float fast_sigmoid(float x) { return __builtin_amdgcn_rcpf(1.0f + __builtin_amdgcn_exp2f(-1.44269504089f * x)); }
__device__ __forceinline__ float fast_silu(float x) { return x * fast_sigmoid(x); }
__device__ __forceinline__ float gelu_tanh(float x) { const float u = 1.5957691216057308f * (x + 0.044715f * x * x * x); return x * fast_sigmoid(u); }

template <class Epi, class Sched, bool ALIGN_EPI, bool MAP62>
__device__ __forceinline__ void gemm_phase(PG8_LAS unsigned char* lds, const int lda, const int ldb, const Sched& S, const Epi& E) {
    const int tid = threadIdx.x, wid = __builtin_amdgcn_readfirstlane(tid >> 6), lane = tid & 63, wr = wid >> 2, wc = wid & 3, fr = lane & 15, fq = lane >> 4;
    unsigned voffA[2], voffB[2];
#pragma unroll
    for (int i = 0; i < 2; ++i) { int R, C; stage_rc(tid * 16 + i * 8192, R, C); const int Rb = Epi::PERM ? ((R & ~31) + perm32(R & 31)) : R; const int Ra = MAP62 ? (R - 2 * (R >> 6)) : R;
        voffA[i] = (unsigned)(Ra * lda + C) * 2u; voffB[i] = (unsigned)(Rb * ldb + C) * 2u; }
    const size_t kstep = (size_t)(BK * 2);
    const size_t hstepA = (size_t)(MAP62 ? 124 : 128) * lda * 2, hstepB = (size_t)HALF * ldb * 2;
    const unsigned ldsw = (unsigned)wid * 1024u;
    const int aoff = lds_byte(wr * 64 + fr, fq * 8), boff = lds_byte(wc * 32 + fr, fq * 8);
#define PG8_SA(b, h) (((b) * 2 + (h)) * HTB)
#define PG8_SB(b, h) ((4 + (b) * 2 + (h)) * HTB)
#define PG8_STAGE(bufoff, gbase, voff) do { _Pragma("unroll") for (int _i = 0; _i < 2; ++_i) \
        __builtin_amdgcn_global_load_lds((const unsigned*)((const char*)(gbase) + (voff)[_i]), (PG8_LAS unsigned*)(lds + (bufoff) + ldsw + _i * 8192), 16, 0, 0); } while (0)
#define PG8_LDA(dst, b, h) do { _Pragma("unroll") for (int m = 0; m < 4; ++m) _Pragma("unroll") for (int k = 0; k < 2; ++k) dst[m][k] = *(const PG8_LAS bf16x8*)(lds + PG8_SA(b, h) + aoff + m * 2048 + k * 1024); } while (0)
#define PG8_LDB(dst, b, h) do { _Pragma("unroll") for (int n = 0; n < 2; ++n) _Pragma("unroll") for (int k = 0; k < 2; ++k) dst[n][k] = *(const PG8_LAS bf16x8*)(lds + PG8_SB(b, h) + boff + n * 2048 + k * 1024); } while (0)
#define PG8_MMA(ai, bj, At, Bt) do { __builtin_amdgcn_s_setprio(1); _Pragma("unroll") for (int m = 0; m < 4; ++m) _Pragma("unroll") for (int n = 0; n < 2; ++n) _Pragma("unroll") for (int k = 0; k < 2; ++k) \
        acc[ai][bj][m][n] = __builtin_amdgcn_mfma_f32_16x16x32_bf16(Bt[n][k], At[m][k], acc[ai][bj][m][n], 0, 0, 0); __builtin_amdgcn_s_setprio(0); } while (0)
#define PG8_WAIT_V(n) asm volatile("s_waitcnt vmcnt(" #n ")" ::: "memory")
#define PG8_WAIT_L(n) asm volatile("s_waitcnt lgkmcnt(" #n ")" ::: "memory")
#define PG8_BAR __builtin_amdgcn_s_barrier()
#define PG8_SCHED __builtin_amdgcn_sched_barrier(0)
    Unit cur, nxt; int ui = 0;
    if (!S.next(0, cur)) return;
    f32x4 acc[2][2][4][2];
#pragma unroll
    for (int a = 0; a < 2; ++a)
#pragma unroll
        for (int b = 0; b < 2; ++b)
#pragma unroll
            for (int m = 0; m < 4; ++m)
#pragma unroll
                for (int n = 0; n < 2; ++n) acc[a][b][m][n] = (f32x4){0.f, 0.f, 0.f, 0.f};
    bf16x8 At[4][2], B0[2][2], B1[2][2];
    const char* cA = cur.A; const char* cB = cur.B;
    PG8_STAGE(PG8_SB(0, 0), cB, voffB); PG8_STAGE(PG8_SB(0, 1), cB + hstepB, voffB); PG8_STAGE(PG8_SA(0, 0), cA, voffA); PG8_STAGE(PG8_SA(0, 1), cA + hstepA, voffA);
    if (wr == 1) PG8_BAR;
    PG8_WAIT_V(2); PG8_BAR;
    PG8_STAGE(PG8_SB(1, 0), cB + kstep, voffB); PG8_STAGE(PG8_SA(1, 0), cA + kstep, voffA); PG8_STAGE(PG8_SB(1, 1), cB + hstepB + kstep, voffB);
    PG8_WAIT_V(6); PG8_BAR;
    for (;;) {
        const bool has_next = S.next(ui + 1, nxt);
        const char* nA = has_next ? nxt.A : cA; const char* nB = has_next ? nxt.B : cB;
        const int nt = cur.nt;
        for (int t = 0; t < nt; t += 2) {
            const bool last = (t == nt - 2);
            const char* a1 = cA + (size_t)(t + 1) * kstep;
            const char* a2 = last ? nA : cA + (size_t)(t + 2) * kstep; const char* b2 = last ? nB : cB + (size_t)(t + 2) * kstep;
            const char* a3 = a2 + kstep; const char* b3 = b2 + kstep;
            PG8_LDB(B0, 0, 0); PG8_LDB(B1, 0, 1); PG8_SCHED; PG8_LDA(At, 0, 0); PG8_STAGE(PG8_SA(1, 1), a1 + hstepA, voffA);
            PG8_WAIT_V(8); PG8_WAIT_L(0); PG8_BAR; PG8_MMA(0, 0, At, B0); PG8_MMA(0, 1, At, B1); PG8_BAR; PG8_SCHED;
            PG8_LDA(At, 0, 1); PG8_STAGE(PG8_SB(0, 0), b2, voffB); PG8_STAGE(PG8_SB(0, 1), b2 + hstepB, voffB); PG8_STAGE(PG8_SA(0, 0), a2, voffA);
            PG8_WAIT_V(8); PG8_WAIT_L(0); PG8_BAR; PG8_MMA(1, 0, At, B0); PG8_MMA(1, 1, At, B1); PG8_BAR; PG8_SCHED;
            PG8_LDB(B0, 1, 0); PG8_LDB(B1, 1, 1); PG8_SCHED; PG8_LDA(At, 1, 0); PG8_STAGE(PG8_SA(0, 1), a2 + hstepA, voffA);
            PG8_WAIT_V(8); PG8_WAIT_L(0); PG8_BAR; PG8_MMA(0, 0, At, B0); PG8_MMA(0, 1, At, B1); PG8_BAR; PG8_SCHED;
            PG8_LDA(At, 1, 1); PG8_STAGE(PG8_SB(1, 0), b3, voffB); PG8_STAGE(PG8_SB(1, 1), b3 + hstepB, voffB); PG8_STAGE(PG8_SA(1, 0), a3, voffA);
            PG8_WAIT_V(8); PG8_WAIT_L(0); PG8_BAR; PG8_MMA(1, 0, At, B0); PG8_MMA(1, 1, At, B1); PG8_BAR; PG8_SCHED;
        }
        if constexpr (ALIGN_EPI) { if (wr == 0) PG8_BAR; }
        E(acc, cur, wr, wc, fr, fq);
        if (!has_next) break;
#pragma unroll
        for (int a = 0; a < 2; ++a)
#pragma unroll
            for (int b = 0; b < 2; ++b)
#pragma unroll
                for (int m = 0; m < 4; ++m)
#pragma unroll
                    for (int n = 0; n < 2; ++n) acc[a][b][m][n] = (f32x4){0.f, 0.f, 0.f, 0.f};
        cur = nxt; cA = nA; cB = nB; ++ui;
        if constexpr (ALIGN_EPI) { if (wr == 1) PG8_BAR; }
    }
    PG8_WAIT_V(0);
    if constexpr (!ALIGN_EPI) { if (wr == 0) PG8_BAR; }
    PG8_BAR;
#undef PG8_SA
#undef PG8_SB
#undef PG8_STAGE
#undef PG8_LDA
#undef PG8_LDB
#undef PG8_MMA
#undef PG8_WAIT_V
#undef PG8_WAIT_L
#undef PG8_BAR
#undef PG8_SCHED
}
}

using pg8::bf16_t; using pg8::f32x4; using pg8::f32x2; using pg8::u32x4; using pg8::u32x2; using pg8::bf16x8; using pg8::Unit;
using pg8::cvt_pk_bf16; using pg8::bf_lo; using pg8::bf_hi; using pg8::fast_sigmoid; using pg8::fast_silu; using pg8::gelu_tanh;

constexpr int NWAVES = 8;
constexpr int RING_BYTES = 131072, LDSCTL_OFF = RING_BYTES, MISC_OFF = LDSCTL_OFF + 320, LDS_BYTES = 147456;
#define GAS __attribute__((address_space(1)))
#define LAS __attribute__((address_space(3)))
typedef GAS unsigned gu32;
#define RLX_AGENT __ATOMIC_RELAXED, __HIP_MEMORY_SCOPE_AGENT
#define LDS_WAIT() asm volatile("s_waitcnt lgkmcnt(0)" ::: "memory")
__device__ __forceinline__ unsigned f2bf(float f) { unsigned u = __builtin_bit_cast(unsigned, f); return (u + 0x7fffu + ((u >> 16) & 1u)) >> 16; }
__device__ __forceinline__ unsigned pk2(float lo, float hi) { return f2bf(lo) | (f2bf(hi) << 16); }
__device__ __forceinline__ float bf2f(bf16_t h) { return __builtin_bit_cast(float, (unsigned)h << 16); }
__device__ __forceinline__ float wave_sum(float v) {
#pragma unroll
    for (int o = 1; o < 64; o <<= 1) v += __shfl_xor(v, o);
    return v;
}

#define XB_TMO      128
#define XB_XCNT(j)  (256  + 64 * (j))
#define XB_XSUB(j)  (1280 + 64 * (j))
#define XB_XGEN(j)  (2304 + 64 * (j))
#define XB_TOP      3328
#define XB_TOPGEN   3392
#define XCD_BAR_WORDS 3456
#define XB_SPIN_CAP (1u << 20)
__device__ __forceinline__ unsigned xb_ld(unsigned* p)              { return __hip_atomic_load(p, __ATOMIC_RELAXED, __HIP_MEMORY_SCOPE_AGENT); }
__device__ __forceinline__ unsigned xb_add(unsigned* p, unsigned v) { return __hip_atomic_fetch_add(p, v, __ATOMIC_RELAXED, __HIP_MEMORY_SCOPE_AGENT); }
__device__ __forceinline__ unsigned xb_xcc_id() { return (unsigned)__builtin_amdgcn_s_getreg((3 << 11) | 20) & 0xFu; }
#define XB_SPIN(cond, bar) do { unsigned _sp = 0; while (cond) { __builtin_amdgcn_s_sleep(1); \
    if ((++_sp & 255u) == 0u) { if (xb_ld(&(bar)[XB_TMO])) break; if (_sp > XB_SPIN_CAP) { atomicAdd(&(bar)[XB_TMO], 1u); break; } } } } while (0)
struct XcdBarrier { unsigned* bar; unsigned x; volatile LAS unsigned* st; };
__device__ __forceinline__ XcdBarrier xcd_barrier_post(unsigned* bar, volatile LAS unsigned* st) {
    XcdBarrier b; b.bar = bar; b.x = xb_xcc_id(); b.st = st;
    if (threadIdx.x == 0) (void)xb_add(&bar[XB_XCNT(b.x)], 1u);
    return b;
}
__device__ __forceinline__ void xcd_barrier_complete(unsigned* bar, unsigned x, unsigned& nloc, unsigned& nx) {
    const unsigned G = gridDim.x * gridDim.y * gridDim.z;
    unsigned sum, cnt, mine, sp = 0u;
    for (;;) {
        sum = 0u; cnt = 0u; mine = 0u;
#pragma unroll
        for (unsigned j = 0; j < 16; ++j) { const unsigned c = xb_ld(&bar[XB_XCNT(j)]); sum += c; cnt += (c > 0u) ? 1u : 0u; mine = (j == x) ? c : mine; }
        if (sum == G) break;
        __builtin_amdgcn_s_sleep(1);
        if ((++sp & 255u) == 0u) { if (xb_ld(&bar[XB_TMO])) break; if (sp > XB_SPIN_CAP) { atomicAdd(&bar[XB_TMO], 1u); break; } }
    }
    nloc = mine > 0u ? mine : 1u; nx = cnt > 0u ? cnt : 1u;
}
__device__ __forceinline__ void xcd_barrier(const XcdBarrier& b) {
    asm volatile("s_waitcnt vmcnt(0)" ::: "memory");
    __syncthreads();
    if (threadIdx.x == 0) {
        unsigned* bar = b.bar;
        __builtin_amdgcn_s_waitcnt(0);
        unsigned nloc = b.st[0], nx = b.st[1];
        if (nloc == 0u) { xcd_barrier_complete(bar, b.x, nloc, nx); b.st[0] = nloc; b.st[1] = nx; }
        const unsigned old = xb_add(&bar[XB_XSUB(b.x)], 1u);
        const unsigned gen = old / nloc;
        if (old + 1u == (gen + 1u) * nloc) {
            __builtin_amdgcn_fence(__ATOMIC_RELEASE, "agent");
            asm volatile("s_waitcnt vmcnt(0)" ::: "memory");
            const unsigned og = xb_add(&bar[XB_TOP], 1u);
            const unsigned tg = og / nx;
            if (og + 1u == (tg + 1u) * nx) xb_add(&bar[XB_TOPGEN], 1u);
            else XB_SPIN(xb_ld(&bar[XB_TOPGEN]) == tg, bar);
            __builtin_amdgcn_fence(__ATOMIC_ACQUIRE, "agent");
            xb_add(&bar[XB_XGEN(b.x)], 1u);
            asm volatile("s_waitcnt vmcnt(0)" ::: "memory");
        } else {
            XB_SPIN(xb_ld(&bar[XB_XGEN(b.x)]) == gen, bar);
            __builtin_amdgcn_fence(__ATOMIC_ACQUIRE, "agent");
            asm volatile("s_waitcnt vmcnt(0)" ::: "memory");
        }
    }
    __syncthreads();
}

struct Frame {
    LAS unsigned char* lds; volatile LAS unsigned* MISC; gu32* ctl;
    int tid, lane, wave, vcu, G;
    const float* in[23]; float* out; unsigned char* ws;
};
constexpr int CW_BAR = 4096;

__device__ __forceinline__ void p0_transpose_item(const float* W, int ldw, int k0, int c0, const float* sc, bf16_t* WT, int ldt, int n0, int kd0, LAS float* scr, int lane) {
#pragma unroll 8
    for (int i = 0; i < 32; ++i) { const int kk = 2 * i + (lane >> 5); const float s = sc ? sc[k0 + kk] : 1.0f; scr[kk * 33 + (lane & 31)] = W[(size_t)(k0 + kk) * ldw + c0 + (lane & 31)] * s; }
    LDS_WAIT(); asm volatile("" ::: "memory");
    const int c = lane & 7;
#pragma unroll
    for (int j = 0; j < 4; ++j) { const int n = (lane >> 3) + 8 * j; const LAS float* s = scr + (8 * c) * 33 + n;
        u32x4 o; o.x = pk2(s[0 * 33], s[1 * 33]); o.y = pk2(s[2 * 33], s[3 * 33]); o.z = pk2(s[4 * 33], s[5 * 33]); o.w = pk2(s[6 * 33], s[7 * 33]);
        *(u32x4*)(WT + (size_t)(n0 + n) * ldt + kd0 + 8 * c) = o; }
    LDS_WAIT(); asm volatile("" ::: "memory");
}
__device__ __forceinline__ void p0_prologue(Frame& F) {
    LAS float* scr = (LAS float*)(F.lds + F.wave * 16384);
    const int gw = F.vcu * NWAVES + F.wave, NGW = F.G * NWAVES, lane = F.lane;
    const float* norm1_w = F.in[1]; const float* w_in = F.in[2]; const float* ssd_norm_w = F.in[9]; const float* w_branch = F.in[15];
    const float* w_out = F.in[16]; const float* norm2_w = F.in[17]; const float* w_up = F.in[18]; const float* w_down = F.in[21];
    bf16_t* W1t = (bf16_t*)((unsigned char*)F.out + DO_W1T); bf16_t* Bcat = (bf16_t*)(F.ws + WS_BCAT); bf16_t* Woutt = (bf16_t*)(F.ws + WS_WOUT);
    bf16_t* Wupt = (bf16_t*)(F.ws + WS_WUP); bf16_t* Wdownt = (bf16_t*)(F.ws + WS_WDOWN);
    constexpr int I_W1 = 16 * 225, I_GA = 16 * 32, I_PA = 32 * 32, I_PB = 16 * 32, I_GB = 16 * 32, I_WO = 16 * 32, I_UP = 16 * 176, I_DN = 44 * 32;
    constexpr int NITEMS = I_W1 + I_GA + I_PA + I_PB + I_GB + I_WO + I_UP + I_DN;
    for (int it = gw; it < NITEMS; it += NGW) {
        int r = it;
        if (r < I_W1) { const int kb = r / 225, nb = r % 225, n = 32 * nb; const int c = n < 5120 ? n : (n < 7168 ? n + 32 : n - 2048);
            p0_transpose_item(w_in, 9248, 64 * kb, c, norm1_w, W1t, D, n, 64 * kb, scr, lane); continue; } r -= I_W1;
        if (r < I_GA) { const int kb = r / 32, nb = r % 32; p0_transpose_item(w_in, 9248, 64 * kb, 7200 + 32 * nb, norm1_w, Bcat, BCAT_LD, 32 * nb, 64 * kb, scr, lane); continue; } r -= I_GA;
        if (r < I_PA) { const int kb = r / 32, nb = r % 32; p0_transpose_item(w_branch, D, 64 * kb, 32 * nb, ssd_norm_w, Bcat, BCAT_LD, 32 * nb, 1024 + 64 * kb, scr, lane); continue; } r -= I_PA;
        if (r < I_PB) { const int kb = r / 32, nb = r % 32; p0_transpose_item(w_branch + (size_t)DI * D, D, 64 * kb, 32 * nb, nullptr, Bcat, BCAT_LD, 32 * nb, 3072 + 64 * kb, scr, lane); continue; } r -= I_PB;
        if (r < I_GB) { const int kb = r / 32, nb = r % 32; p0_transpose_item(w_in, 9248, 64 * kb, 8224 + 32 * nb, norm1_w, Bcat, BCAT_LD, 32 * nb, 4096 + 64 * kb, scr, lane); continue; } r -= I_GB;
        if (r < I_WO) { const int kb = r / 32, nb = r % 32; p0_transpose_item(w_out, D, 64 * kb, 32 * nb, nullptr, Woutt, D, 32 * nb, 64 * kb, scr, lane); continue; } r -= I_WO;
        if (r < I_UP) { const int kb = r / 176, nb = r % 176, n = 32 * nb, j = n >> 8, w = n & 255; const int c = w < 128 ? 128 * j + w : FF + 128 * j + (w - 128);
            p0_transpose_item(w_up, 2 * FF, 64 * kb, c, norm2_w, Wupt, D, n, 64 * kb, scr, lane); continue; } r -= I_UP;
        { const int kb = r / 32, nb = r % 32; p0_transpose_item(w_down, D, 64 * kb, 32 * nb, nullptr, Wdownt, FF, 32 * nb, 64 * kb, scr, lane); }
    }
    const float* x = F.in[0]; bf16_t* ACAT = (bf16_t*)(F.ws + WS_ACAT);
    for (int m = gw; m < M; m += NGW) {
        const GAS f32x4* xr = (const GAS f32x4*)(x + (size_t)m * D) + lane;
        f32x4 v[4]; float s = 0.f;
#pragma unroll
        for (int j = 0; j < 4; ++j) { v[j] = xr[64 * j]; s += (v[j].x * v[j].x + v[j].y * v[j].y) + (v[j].z * v[j].z + v[j].w * v[j].w); }
        const float rstd = 1.f / sqrtf(wave_sum(s) * (1.f / D) + NORM_EPS);
        GAS unsigned long long* o8 = (GAS unsigned long long*)(ACAT + (size_t)m * ACAT_LD) + lane;
#pragma unroll
        for (int j = 0; j < 4; ++j) o8[64 * j] = (unsigned long long)pk2(v[j].x * rstd, v[j].y * rstd) | ((unsigned long long)pk2(v[j].z * rstd, v[j].w * rstd) << 32);
    }
}

struct SchedP1 {
    const char* A; const char* B; int G, c;
    __device__ __forceinline__ bool next(int i, Unit& u) const {
        const int L = i * G + c; if (L >= 64 * 28) return false;
        pg8::tile_of(L, 64, 28, u.pm, u.pn); u.nt = D / 64; u.kind = 0;
        u.A = A + (size_t)u.pm * 256 * ACAT_LD * 2; u.B = B + (size_t)u.pn * 256 * D * 2; return true;
    }
};
struct EpiP1 {
    static constexpr bool PERM = true;
    bf16_t* ACAT; bf16_t* XBC; bf16_t* V; bf16_t* HALO; float* VST; const float* uv_b;
    __device__ __forceinline__ void operator()(const f32x4 (&acc)[2][2][4][2], const Unit& u, int wr, int wc, int fr, int fq) const {
        const int row0 = u.pm * 256 + wr * 64 + fr, ct = u.pn * 256 + wc * 32 + 8 * fq;
        if (u.pn < 8) {
#pragma unroll
            for (int ai = 0; ai < 2; ++ai)
#pragma unroll
                for (int m = 0; m < 4; ++m) { const int r = row0 + ai * 128 + m * 16;
#pragma unroll
                    for (int bj = 0; bj < 2; ++bj) { const f32x4 v0 = acc[ai][bj][m][0], v1 = acc[ai][bj][m][1]; u32x4 w;
                        w.x = cvt_pk_bf16(fast_silu(v0[0]), fast_silu(v0[1])); w.y = cvt_pk_bf16(fast_silu(v0[2]), fast_silu(v0[3]));
                        w.z = cvt_pk_bf16(fast_silu(v1[0]), fast_silu(v1[1])); w.w = cvt_pk_bf16(fast_silu(v1[2]), fast_silu(v1[3]));
                        *(u32x4*)(ACAT + (size_t)r * ACAT_LD + 1024 + ct + bj * 128) = w; } }
        } else if (u.pn < 20) {
#pragma unroll
            for (int ai = 0; ai < 2; ++ai)
#pragma unroll
                for (int m = 0; m < 4; ++m) { const int r = row0 + ai * 128 + m * 16;
#pragma unroll
                    for (int bj = 0; bj < 2; ++bj) { const f32x4 v0 = acc[ai][bj][m][0], v1 = acc[ai][bj][m][1]; u32x4 w;
                        w.x = cvt_pk_bf16(v0[0], v0[1]); w.y = cvt_pk_bf16(v0[2], v0[3]); w.z = cvt_pk_bf16(v1[0], v1[1]); w.w = cvt_pk_bf16(v1[2], v1[3]);
                        const int c = ct + bj * 128 - 2048;
                        *(u32x4*)(XBC + (size_t)r * XBCW + c) = w;
                        if ((r & 127) >= 125) *(u32x4*)(HALO + (size_t)((r >> 7) * 3 + (r & 127) - 125) * XBCW + c) = w; } }
        } else {
            const bool isv = u.pn >= 24;
#pragma unroll
            for (int ai = 0; ai < 2; ++ai)
#pragma unroll
                for (int m = 0; m < 4; ++m) { const int r = row0 + ai * 128 + m * 16; float s = 0.f, q = 0.f;
#pragma unroll
                    for (int bj = 0; bj < 2; ++bj) { const int c = ct + bj * 128 - 5120;
                        const f32x4 b0 = *(const f32x4*)(uv_b + c), b1 = *(const f32x4*)(uv_b + c + 4);
                        f32x4 v0 = acc[ai][bj][m][0] + b0, v1 = acc[ai][bj][m][1] + b1;
#pragma unroll
                        for (int i = 0; i < 4; ++i) { v0[i] = gelu_tanh(v0[i]); v1[i] = gelu_tanh(v1[i]); s += v0[i] + v1[i]; q += v0[i] * v0[i] + v1[i] * v1[i]; }
                        u32x4 w; w.x = cvt_pk_bf16(v0[0], v0[1]); w.y = cvt_pk_bf16(v0[2], v0[3]); w.z = cvt_pk_bf16(v1[0], v1[1]); w.w = cvt_pk_bf16(v1[2], v1[3]);
                        if (!isv) *(u32x4*)(ACAT + (size_t)r * ACAT_LD + 3072 + c) = w; else *(u32x4*)(V + (size_t)r * D + (c - 1024)) = w; }
                    if (isv) { s += __shfl_xor(s, 16); s += __shfl_xor(s, 32); q += __shfl_xor(q, 16); q += __shfl_xor(q, 32);
                        if (fq == 0) *(f32x2*)(VST + ((size_t)r * 16 + (u.pn - 24) * 4 + wc) * 2) = (f32x2){s, q}; } }
        }
    }
};
__device__ __forceinline__ void p1_dt(Frame& F) {
    const bf16_t* XN = (const bf16_t*)(F.ws + WS_ACAT); const bf16_t* Wdt = (const bf16_t*)((unsigned char*)F.out + DO_W1T) + (size_t)N1 * D;
    float* DT = (float*)((unsigned char*)F.out + DO_DT); const float* dt_bias = F.in[6];
    const int gw = F.vcu * NWAVES + F.wave, NGW = F.G * NWAVES, fr = F.lane & 15, fq = F.lane >> 4;
    for (int item = gw; item < 2048; item += NGW) { const int rb = item >> 1, nb = item & 1;
        f32x4 acc = (f32x4){0.f, 0.f, 0.f, 0.f};
        const bf16_t* ap = XN + (size_t)(rb * 16 + fr) * ACAT_LD + fq * 8; const bf16_t* bp = Wdt + (size_t)(nb * 16 + fr) * D + fq * 8;
#pragma unroll 4
        for (int ks = 0; ks < 32; ++ks) { const bf16x8 a = *(const bf16x8*)(ap + ks * 32), b = *(const bf16x8*)(bp + ks * 32); acc = __builtin_amdgcn_mfma_f32_16x16x32_bf16(a, b, acc, 0, 0, 0); }
        const float bias = dt_bias[nb * 16 + fr];
#pragma unroll
        for (int j = 0; j < 4; ++j) { const float v = acc[j] + bias; const float sp = fmaxf(v, 0.f) + log1pf(expf(-fabsf(v))); DT[(size_t)(rb * 16 + 4 * fq + j) * NH + nb * 16 + fr] = sp; }
    }
}

__device__ __forceinline__ void p2_ssd_naive(Frame& F, int b, int h) {
    const bf16_t* XBC = (const bf16_t*)(F.ws + WS_XBC); const float* DT = (const float*)((unsigned char*)F.out + DO_DT); bf16_t* ACAT = (bf16_t*)(F.ws + WS_ACAT); float* SSQ = (float*)((unsigned char*)F.out + DO_SSQ);
    const float* conv_w = F.in[4]; const float* conv_b = F.in[5]; const float* a_log = F.in[7]; const float* d_skip = F.in[8];
    LAS float* sB = (LAS float*)F.lds; LAS float* sC = sB + 2 * NS;
    const int g = h >> 3, p = F.lane;
    const float a = -expf(a_log[h]), dsk = d_skip[h];
    const int chx = h * HD + p;
    int ch[4]; ch[0] = DI + g * NS + p; ch[1] = ch[0] + 64; ch[2] = DI + NG * NS + g * NS + p; ch[3] = ch[2] + 64;
    float wx[4], wq[4][4]; const float bx = conv_b[chx]; float bq[4];
#pragma unroll
    for (int k = 0; k < 4; ++k) wx[k] = conv_w[k * XBCW + chx];
#pragma unroll
    for (int j = 0; j < 4; ++j) { bq[j] = conv_b[ch[j]];
#pragma unroll
        for (int k = 0; k < 4; ++k) wq[j][k] = conv_w[k * XBCW + ch[j]]; }
    float hs[NS];
#pragma unroll
    for (int n = 0; n < NS; ++n) hs[n] = 0.f;
    float xh[3] = {0.f, 0.f, 0.f}, qh[4][3];
#pragma unroll
    for (int j = 0; j < 4; ++j) { qh[j][0] = 0.f; qh[j][1] = 0.f; qh[j][2] = 0.f; }
    size_t row = (size_t)b * SEQ;
    bf16_t nx = XBC[row * XBCW + chx], nq[4];
#pragma unroll
    for (int j = 0; j < 4; ++j) nq[j] = XBC[row * XBCW + ch[j]];
    float ndt = DT[row * NH + h]; bf16_t nz = ACAT[row * ACAT_LD + 1024 + chx];
    for (int t = 0; t < SEQ; ++t) {
        row = (size_t)b * SEQ + t;
        const float xc = bf2f(nx); float qc[4];
#pragma unroll
        for (int j = 0; j < 4; ++j) qc[j] = bf2f(nq[j]);
        const float dt = ndt; const float zs = bf2f(nz);
        if (t + 1 < SEQ) { const size_t r1 = row + 1; nx = XBC[r1 * XBCW + chx];
#pragma unroll
            for (int j = 0; j < 4; ++j) nq[j] = XBC[r1 * XBCW + ch[j]];
            ndt = DT[r1 * NH + h]; nz = ACAT[r1 * ACAT_LD + 1024 + chx]; }
        const float xv = fast_silu(bx + wx[0] * xh[0] + wx[1] * xh[1] + wx[2] * xh[2] + wx[3] * xc);
        xh[0] = xh[1]; xh[1] = xh[2]; xh[2] = xc;
        const int buf = (t & 1) * NS;
#pragma unroll
        for (int j = 0; j < 4; ++j) { const float v = fast_silu(bq[j] + wq[j][0] * qh[j][0] + wq[j][1] * qh[j][1] + wq[j][2] * qh[j][2] + wq[j][3] * qc[j]);
            qh[j][0] = qh[j][1]; qh[j][1] = qh[j][2]; qh[j][2] = qc[j];
            if (j < 2) sB[buf + p + 64 * j] = v; else sC[buf + p + 64 * (j - 2)] = v; }
        LDS_WAIT(); asm volatile("" ::: "memory");
        const float dA = expf(dt * a), xdt = xv * dt; float y = 0.f;
#pragma unroll
        for (int n = 0; n < NS; n += 4) { const f32x4 Bv = *(const LAS f32x4*)&sB[buf + n], Cv = *(const LAS f32x4*)&sC[buf + n];
#pragma unroll
            for (int i = 0; i < 4; ++i) { hs[n + i] = hs[n + i] * dA + xdt * Bv[i]; y += Cv[i] * hs[n + i]; } }
        y += dsk * xv;
        const float yz = y * zs;
        ACAT[row * ACAT_LD + 1024 + chx] = (bf16_t)f2bf(yz);
        const float ssq = wave_sum(yz * yz);
        if (p == 0) { SSQ[row * 64 + 2 * h] = ssq; SSQ[row * 64 + 2 * h + 1] = 0.f; }
    }
}
__device__ __forceinline__ void p2_sgu_naive(Frame& F, int item, LAS float* sv, LAS float* sst) {
    const bf16_t* V = (const bf16_t*)((unsigned char*)F.out + DO_V); const float* VST = (const float*)((unsigned char*)F.out + DO_VST); bf16_t* ACAT = (bf16_t*)(F.ws + WS_ACAT);
    const float* ln_w = F.in[11]; const float* ln_b = F.in[12]; const float* w_sp = F.in[13]; const float* b_sp = F.in[14];
    const int bc = item >> 5, g = (item >> 2) & 7, qd = item & 3, dl = F.lane & 31, th = F.lane >> 5, d = qd * 32 + dl; const size_t row0 = (size_t)bc * CHUNK;
    for (int s = F.lane; s < CHUNK; s += 64) { float su = 0.f, sq = 0.f;
        for (int j = 0; j < 16; ++j) { su += VST[((row0 + s) * 16 + j) * 2]; sq += VST[((row0 + s) * 16 + j) * 2 + 1]; }
        const float mu = su * (1.0f / D); const float var = fmaxf(sq * (1.0f / D) - mu * mu, 0.f); sst[2 * s] = mu; sst[2 * s + 1] = 1.0f / sqrtf(var + LN_EPS); }
    LDS_WAIT(); asm volatile("" ::: "memory");
    const float lw = ln_w[g * NS + d], lb = ln_b[g * NS + d];
    for (int s = th; s < CHUNK; s += 2) sv[s * 32 + dl] = (bf2f(V[(row0 + s) * D + g * NS + d]) - sst[2 * s]) * sst[2 * s + 1] * lw + lb;
    LDS_WAIT(); asm volatile("" ::: "memory");
    for (int t = th; t < CHUNK; t += 2) { const float* wr = w_sp + ((size_t)g * CHUNK + t) * CHUNK; float mix = b_sp[g * CHUNK + t];
        for (int s = 0; s <= t; ++s) mix += wr[s] * sv[s * 32 + dl];
        bf16_t* up = ACAT + (row0 + t) * ACAT_LD + 3072 + g * NS + d;
        *up = (bf16_t)f2bf(bf2f(*up) * mix); }
    LDS_WAIT(); asm volatile("" ::: "memory");
}
__device__ __forceinline__ void p2_naive(Frame& F) {
    if (blockIdx.x < BATCH * NH) { if (F.wave == 0) p2_ssd_naive(F, (int)blockIdx.x >> 5, (int)blockIdx.x & 31); }
    else { const int wv = ((int)blockIdx.x - BATCH * NH) * NWAVES + F.wave, nwv = (F.G - BATCH * NH) * NWAVES;
        LAS float* sv = (LAS float*)(F.lds + F.wave * 16384); LAS float* sst = (LAS float*)(F.lds + MISC_OFF + 128 + F.wave * 1024);
        for (int item = wv; item < (M / CHUNK) * 32; item += nwv) p2_sgu_naive(F, item, sv, sst); }
}

struct SchedP3 {
    const char* A; const char* B; int pm, pn;
    __device__ __forceinline__ bool next(int i, Unit& u) const {
        if (i >= 4) return false;
        u.pm = pm; u.pn = pn; u.kind = i;
        const int acol = (i == 1) ? 1024 : (i == 3 ? 3072 : 0), bcol = (i == 0) ? 0 : (i == 1 ? 1024 : (i == 2 ? 4096 : 3072));
        u.nt = (i == 1) ? 32 : 16;
        u.A = A + ((size_t)pm * 256 * ACAT_LD + acol) * 2; u.B = B + ((size_t)pn * 256 * BCAT_LD + bcol) * 2; return true;
    }
};
struct EpiP3 {
    static constexpr bool PERM = true;
    bf16_t* G; bf16_t* T; const float* b_gate; const float* SSQ;
    __device__ __forceinline__ void operator()(const f32x4 (&acc)[2][2][4][2], const Unit& u, int wr, int wc, int fr, int fq) const {
        const int row0 = u.pm * 256 + wr * 64 + fr, ct = u.pn * 256 + wc * 32 + 8 * fq;
        if (u.kind == 0 || u.kind == 2) {
            const float* bg = b_gate + (u.kind == 2 ? 1024 : 0);
#pragma unroll
            for (int bj = 0; bj < 2; ++bj) { const int c = ct + bj * 128; const f32x4 b0 = *(const f32x4*)(bg + c), b1 = *(const f32x4*)(bg + c + 4);
#pragma unroll
                for (int ai = 0; ai < 2; ++ai)
#pragma unroll
                    for (int m = 0; m < 4; ++m) { const int r = row0 + ai * 128 + m * 16; const f32x4 v0 = acc[ai][bj][m][0] + b0, v1 = acc[ai][bj][m][1] + b1; u32x4 w;
                        w.x = cvt_pk_bf16(fast_sigmoid(v0[0]), fast_sigmoid(v0[1])); w.y = cvt_pk_bf16(fast_sigmoid(v0[2]), fast_sigmoid(v0[3]));
                        w.z = cvt_pk_bf16(fast_sigmoid(v1[0]), fast_sigmoid(v1[1])); w.w = cvt_pk_bf16(fast_sigmoid(v1[2]), fast_sigmoid(v1[3]));
                        *(u32x4*)(G + (size_t)r * D + c) = w; } }
        } else if (u.kind == 1) {
#pragma unroll
            for (int ai = 0; ai < 2; ++ai)
#pragma unroll
                for (int m = 0; m < 4; ++m) { const int r = row0 + ai * 128 + m * 16;
                    float ss = 0.f;
#pragma unroll
                    for (int j = 0; j < 4; ++j) { const f32x4 p = *(const f32x4*)(SSQ + (size_t)r * 64 + fq * 16 + j * 4); ss += (p[0] + p[1]) + (p[2] + p[3]); }
                    ss += __shfl_xor(ss, 16); ss += __shfl_xor(ss, 32);
                    const float rs = 1.0f / sqrtf(ss * (1.0f / DI) + NORM_EPS);
#pragma unroll
                    for (int bj = 0; bj < 2; ++bj) { const int c = ct + bj * 128; const u32x4 g = *(const u32x4*)(G + (size_t)r * D + c); const f32x4 v0 = acc[ai][bj][m][0] * rs, v1 = acc[ai][bj][m][1] * rs; u32x4 w;
                        w.x = cvt_pk_bf16(bf_lo(g.x) * v0[0], bf_hi(g.x) * v0[1]); w.y = cvt_pk_bf16(bf_lo(g.y) * v0[2], bf_hi(g.y) * v0[3]);
                        w.z = cvt_pk_bf16(bf_lo(g.z) * v1[0], bf_hi(g.z) * v1[1]); w.w = cvt_pk_bf16(bf_lo(g.w) * v1[2], bf_hi(g.w) * v1[3]);
                        *(u32x4*)(T + (size_t)r * D + c) = w; } }
        } else {
#pragma unroll
            for (int ai = 0; ai < 2; ++ai)
#pragma unroll
                for (int m = 0; m < 4; ++m) { const int r = row0 + ai * 128 + m * 16;
#pragma unroll
                    for (int bj = 0; bj < 2; ++bj) { const int c = ct + bj * 128; const u32x4 g = *(const u32x4*)(G + (size_t)r * D + c); const u32x4 t = *(const u32x4*)(T + (size_t)r * D + c);
                        const f32x4 v0 = acc[ai][bj][m][0], v1 = acc[ai][bj][m][1]; u32x4 w;
                        w.x = cvt_pk_bf16(bf_lo(t.x) + bf_lo(g.x) * v0[0], bf_hi(t.x) + bf_hi(g.x) * v0[1]); w.y = cvt_pk_bf16(bf_lo(t.y) + bf_lo(g.y) * v0[2], bf_hi(t.y) + bf_hi(g.y) * v0[3]);
                        w.z = cvt_pk_bf16(bf_lo(t.z) + bf_lo(g.z) * v1[0], bf_hi(t.z) + bf_hi(g.z) * v1[1]); w.w = cvt_pk_bf16(bf_lo(t.w) + bf_lo(g.w) * v1[2], bf_hi(t.w) + bf_hi(g.w) * v1[3]);
                        *(u32x4*)(T + (size_t)r * D + c) = w; } }
        }
    }
};

struct SchedSq {
    const char* A; const char* B; int lda, K, c;
    __device__ __forceinline__ bool next(int i, Unit& u) const {
        if (i >= 1 || c >= 256) return false;
        pg8::tile_of(c, 64, 4, u.pm, u.pn); u.nt = K / 64; u.kind = 0;
        u.A = A + (size_t)u.pm * 256 * lda * 2; u.B = B + (size_t)u.pn * 256 * K * 2; return true;
    }
};
template <bool WRITE_BF16> struct EpiRes {
    static constexpr bool PERM = false;
    const float* base; float* out; bf16_t* ob; float* SS;
    __device__ __forceinline__ void operator()(const f32x4 (&acc)[2][2][4][2], const Unit& u, int wr, int wc, int fr, int fq) const {
        const int row0 = u.pm * 256 + wr * 64 + fr, col0 = u.pn * 256 + wc * 32 + 4 * fq;
#pragma unroll
        for (int ai = 0; ai < 2; ++ai)
#pragma unroll
            for (int m = 0; m < 4; ++m) { const int r = row0 + ai * 128 + m * 16; const size_t off = (size_t)r * D + col0; float q = 0.f;
#pragma unroll
                for (int bj = 0; bj < 2; ++bj)
#pragma unroll
                    for (int n = 0; n < 2; ++n) { const size_t o = off + bj * 128 + n * 16; const f32x4 h = *(const f32x4*)(base + o) + acc[ai][bj][m][n];
                        *(f32x4*)(out + o) = h; q += (h[0] * h[0] + h[1] * h[1]) + (h[2] * h[2] + h[3] * h[3]);
                        if (WRITE_BF16) { u32x2 w; w.x = cvt_pk_bf16(h[0], h[1]); w.y = cvt_pk_bf16(h[2], h[3]); *(u32x2*)(ob + o) = w; } }
                q += __shfl_xor(q, 16); q += __shfl_xor(q, 32);
                if (fq == 0) SS[(size_t)r * 16 + u.pn * 4 + wc] = q; }
    }
};

struct SchedP5 {
    const char* A; const char* B; int G, c;
    __device__ __forceinline__ bool next(int i, Unit& u) const {
        const int L = i * G + c; if (L >= 68 * 22) return false;
        pg8::tile_of(L, 68, 22, u.pm, u.pn); u.nt = D / 64;
        const int q = u.pm / 17, ii = u.pm % 17, o = ii < 16 ? 248 * ii : SEQ - 248;
        u.kind = q * SEQ + o;
        u.A = A + ((long)u.kind - 2) * (long)(D * 2); u.B = B + (size_t)u.pn * 256 * D * 2; return true;
    }
};
template <int CTRL> __device__ __forceinline__ float dpp_keep(float oldv, float x) { return __builtin_bit_cast(float, __builtin_amdgcn_update_dpp(__builtin_bit_cast(int, oldv), __builtin_bit_cast(int, x), CTRL, 0xf, 0xf, false)); }
struct EpiP5 {
    static constexpr bool PERM = true;
    bf16_t* ACT; const float* SS2; const float* cw; const float* cb;
    __device__ __forceinline__ void operator()(f32x4 (&acc)[2][2][4][2], const Unit& u, int wr, int wc, int fr, int fq) const {
        const int tok0 = u.kind, ii = u.pm % 17; const int skip = ii < 16 ? 0 : 120; const bool first = (ii == 0);
        const int j0 = u.pn * 128 + wc * 32 + 8 * fq;
#pragma unroll
        for (int ai = 0; ai < 2; ++ai)
#pragma unroll
            for (int m = 0; m < 4; ++m) { const int blk = 2 * ai + wr, lr = 16 * m + fr; const int tok = tok0 + 62 * blk + lr - 2;
                const bool zero = first && blk == 0 && lr < 2;
                const int tokc = zero ? tok0 : tok;
                const f32x4 p = *(const f32x4*)(SS2 + (size_t)tokc * 16 + 4 * fq); float ss = (p[0] + p[1]) + (p[2] + p[3]);
                ss += __shfl_xor(ss, 16); ss += __shfl_xor(ss, 32);
                const float rs = 1.0f / sqrtf(ss * (1.0f / D) + NORM_EPS);
#pragma unroll
                for (int bj = 0; bj < 2; ++bj)
#pragma unroll
                    for (int n = 0; n < 2; ++n) acc[ai][bj][m][n] = zero ? (f32x4){0.f, 0.f, 0.f, 0.f} : acc[ai][bj][m][n] * rs; }
#pragma unroll
        for (int n = 0; n < 2; ++n) {
            f32x4 w0[2], w1[2], w2[2], bb[2];
#pragma unroll
            for (int bj = 0; bj < 2; ++bj) { const int ch = bj * FF + j0 + 4 * n; w0[bj] = *(const f32x4*)(cw + ch); w1[bj] = *(const f32x4*)(cw + 2 * FF + ch); w2[bj] = *(const f32x4*)(cw + 4 * FF + ch); bb[bj] = *(const f32x4*)(cb + ch); }
#pragma unroll
            for (int ai = 0; ai < 2; ++ai) { const int blk = 2 * ai + wr;
#pragma unroll
                for (int m = 3; m >= 0; --m) {
                    f32x4 cv[2];
#pragma unroll
                    for (int bj = 0; bj < 2; ++bj) {
#pragma unroll
                        for (int i = 0; i < 4; ++i) { const float x = acc[ai][bj][m][n][i]; const float xp = m > 0 ? acc[ai][bj][m - 1][n][i] : 0.f;
                            const float s1 = dpp_keep<0x111>(dpp_keep<0x121>(0.f, xp), x);
                            const float s2 = dpp_keep<0x112>(dpp_keep<0x122>(0.f, xp), x);
                            cv[bj][i] = bb[bj][i] + w2[bj][i] * x + w1[bj][i] * s1 + w0[bj][i] * s2; } }
                    const int lr = 16 * m + fr, oi = 62 * blk + lr - 2;
                    u32x2 w; w.x = cvt_pk_bf16(fast_silu(cv[0][0]) * cv[1][0], fast_silu(cv[0][1]) * cv[1][1]); w.y = cvt_pk_bf16(fast_silu(cv[0][2]) * cv[1][2], fast_silu(cv[0][3]) * cv[1][3]);
                    if (lr >= 2 && oi >= skip) *(u32x2*)(ACT + (size_t)(tok0 + oi) * FF + j0 + 4 * n) = w;
                    asm volatile("" ::: "memory");
                }
            }
        }
    }
};

__device__ __forceinline__ void p7_final(Frame& F) {
    const float* SS3 = (const float*)(F.ws + WS_SS3); const float* fw = F.in[22];
    const int gw = F.vcu * NWAVES + F.wave, NGW = F.G * NWAVES, lane = F.lane;
    f32x4 wv[4];
#pragma unroll
    for (int j = 0; j < 4; ++j) wv[j] = *((const f32x4*)fw + lane + 64 * j);
    for (int m = gw; m < M; m += NGW) {
        float ss = lane < 16 ? SS3[(size_t)m * 16 + lane] : 0.f; ss = wave_sum(ss);
        const float rs = 1.0f / sqrtf(ss * (1.0f / D) + NORM_EPS);
        GAS f32x4* o = (GAS f32x4*)(F.out + (size_t)m * D) + lane;
#pragma unroll
        for (int j = 0; j < 4; ++j) { f32x4 v = o[64 * j]; v = v * rs * wv[j]; o[64 * j] = v; }
    }
}

struct Args { const float* in[23]; float* out; unsigned char* ws; int ph_lo, ph_hi, li, pad; };
__global__ void __launch_bounds__(NWAVES * 64, 2) mk_fwd(Args args) {
    extern __shared__ __attribute__((aligned(16))) unsigned char lds[];
    Frame F;
    F.lds = (LAS unsigned char*)lds; F.MISC = (volatile LAS unsigned*)(F.lds + MISC_OFF);
    F.tid = threadIdx.x; F.lane = F.tid & 63; F.wave = __builtin_amdgcn_readfirstlane(F.tid >> 6);
    F.G = gridDim.x; { const int bx = blockIdx.x; F.vcu = (F.G % 8 == 0) ? (bx % 8) * (F.G / 8) + bx / 8 : bx; }
#pragma unroll
    for (int i = 0; i < 23; ++i) F.in[i] = args.in[i];
    F.out = args.out; F.ws = args.ws; F.ctl = (gu32*)(args.ws + WS_CTL);
    for (int u = F.tid; u < (LDS_BYTES - LDSCTL_OFF) / 4; u += NWAVES * 64) ((LAS unsigned*)(F.lds + LDSCTL_OFF))[u] = 0u;
    __syncthreads();
    XcdBarrier bar; bar.bar = (unsigned*)(F.ctl + CW_BAR); bar.x = 0; bar.st = nullptr;
    if (MK_N_LAUNCHES == 1) bar = xcd_barrier_post((unsigned*)(F.ctl + CW_BAR), F.MISC + 8);
#define GRID_BAR() do { if (MK_N_LAUNCHES == 1) xcd_barrier(bar); } while (0)
    const int lo = args.ph_lo, hi = args.ph_hi;
#ifndef PH_MASK
#define PH_MASK 0xff
#endif
#define IN(k) (((PH_MASK >> (k)) & 1) && lo <= (k) && (k) < hi)
    unsigned char* dout = (unsigned char*)F.out;

    if (IN(0)) { p0_prologue(F); GRID_BAR(); }
    if (IN(1)) {
        SchedP1 S{(const char*)(F.ws + WS_ACAT), (const char*)(dout + DO_W1T), F.G, (int)blockIdx.x};
        EpiP1 E{(bf16_t*)(F.ws + WS_ACAT), (bf16_t*)(F.ws + WS_XBC), (bf16_t*)(dout + DO_V), (bf16_t*)(dout + DO_HALO), (float*)(dout + DO_VST), F.in[10]};
        pg8::gemm_phase<EpiP1, SchedP1, true, false>(F.lds, ACAT_LD, D, S, E);
        p1_dt(F);
        GRID_BAR();
    }
    if (IN(2)) { p2_naive(F); GRID_BAR(); }
    if (IN(3)) {
        int pm, pn; pg8::tile_of((int)blockIdx.x, 64, 4, pm, pn);
        SchedP3 S{(const char*)(F.ws + WS_ACAT), (const char*)(F.ws + WS_BCAT), pm, pn};
        EpiP3 E{(bf16_t*)(F.ws + WS_G), (bf16_t*)(F.ws + WS_T), F.in[3], (const float*)(dout + DO_SSQ)};
        if (blockIdx.x < 256) pg8::gemm_phase<EpiP3, SchedP3, true, false>(F.lds, ACAT_LD, BCAT_LD, S, E);
        GRID_BAR();
    }
    if (IN(4)) {
        SchedSq S{(const char*)(F.ws + WS_T), (const char*)(F.ws + WS_WOUT), D, D, (int)blockIdx.x};
        EpiRes<true> E{F.in[0], (float*)(F.ws + WS_H), (bf16_t*)(F.ws + WS_HB), (float*)(F.ws + WS_SS2)};
        pg8::gemm_phase<EpiRes<true>, SchedSq, true, false>(F.lds, D, D, S, E);
        GRID_BAR();
    }
    if (IN(5)) {
        SchedP5 S{(const char*)(F.ws + WS_HB), (const char*)(F.ws + WS_WUP), F.G, (int)blockIdx.x};
        EpiP5 E{(bf16_t*)(F.ws + WS_ACT), (const float*)(F.ws + WS_SS2), F.in[19], F.in[20]};
        pg8::gemm_phase<EpiP5, SchedP5, true, true>(F.lds, D, D, S, E);
        GRID_BAR();
    }
    if (IN(6)) {
        SchedSq S{(const char*)(F.ws + WS_ACT), (const char*)(F.ws + WS_WDOWN), FF, FF, (int)blockIdx.x};
        EpiRes<false> E{(const float*)(F.ws + WS_H), F.out, nullptr, (float*)(F.ws + WS_SS3)};
        pg8::gemm_phase<EpiRes<false>, SchedSq, true, false>(F.lds, FF, FF, S, E);
        GRID_BAR();
    }
    if (IN(7)) p7_final(F);
#undef IN
#undef GRID_BAR
}

__global__ void __launch_bounds__(64) ssd_naive(const bf16_t* XBC, const float* DT, bf16_t* ACAT, float* SSQ,
                                               const float* conv_w, const float* conv_b, const float* a_log, const float* d_skip) {
    __shared__ float sB[2][NS], sC[2][NS];
    const int b = blockIdx.x >> 5, h = blockIdx.x & 31, g = h >> 3, p = threadIdx.x;
    const float a = -expf(a_log[h]), dsk = d_skip[h];
    const int chx = h * HD + p;
    int ch[4]; ch[0] = DI + g * NS + p; ch[1] = ch[0] + 64; ch[2] = DI + NG * NS + g * NS + p; ch[3] = ch[2] + 64;
    float wx[4], wq[4][4]; const float bx = conv_b[chx]; float bq[4];
#pragma unroll
    for (int k = 0; k < 4; ++k) wx[k] = conv_w[k * XBCW + chx];
#pragma unroll
    for (int j = 0; j < 4; ++j) { bq[j] = conv_b[ch[j]];
#pragma unroll
        for (int k = 0; k < 4; ++k) wq[j][k] = conv_w[k * XBCW + ch[j]]; }
    float hs[NS];
#pragma unroll
    for (int n = 0; n < NS; ++n) hs[n] = 0.f;
    float xh[3] = {0.f, 0.f, 0.f}, qh[4][3];
#pragma unroll
    for (int j = 0; j < 4; ++j) { qh[j][0] = 0.f; qh[j][1] = 0.f; qh[j][2] = 0.f; }
    size_t row = (size_t)b * SEQ;
    bf16_t nx = XBC[row * XBCW + chx], nq[4];
#pragma unroll
    for (int j = 0; j < 4; ++j) nq[j] = XBC[row * XBCW + ch[j]];
    float ndt = DT[row * NH + h]; bf16_t nz = ACAT[row * ACAT_LD + 1024 + chx];
    for (int t = 0; t < SEQ; ++t) {
        row = (size_t)b * SEQ + t;
        const float xc = bf2f(nx); float qc[4];
#pragma unroll
        for (int j = 0; j < 4; ++j) qc[j] = bf2f(nq[j]);
        const float dt = ndt; const float zs = bf2f(nz);
        if (t + 1 < SEQ) { const size_t r1 = row + 1; nx = XBC[r1 * XBCW + chx];
#pragma unroll
            for (int j = 0; j < 4; ++j) nq[j] = XBC[r1 * XBCW + ch[j]];
            ndt = DT[r1 * NH + h]; nz = ACAT[r1 * ACAT_LD + 1024 + chx]; }
        const float xv = fast_silu(bx + wx[0] * xh[0] + wx[1] * xh[1] + wx[2] * xh[2] + wx[3] * xc);
        xh[0] = xh[1]; xh[1] = xh[2]; xh[2] = xc;
        const int buf = t & 1;
#pragma unroll
        for (int j = 0; j < 4; ++j) { const float v = fast_silu(bq[j] + wq[j][0] * qh[j][0] + wq[j][1] * qh[j][1] + wq[j][2] * qh[j][2] + wq[j][3] * qc[j]);
            qh[j][0] = qh[j][1]; qh[j][1] = qh[j][2]; qh[j][2] = qc[j];
            if (j < 2) sB[buf][p + 64 * j] = v; else sC[buf][p + 64 * (j - 2)] = v; }
        __syncthreads();
        const float dA = expf(dt * a), xdt = xv * dt; float y = 0.f;
#pragma unroll
        for (int n = 0; n < NS; n += 4) { const f32x4 Bv = *(const f32x4*)&sB[buf][n], Cv = *(const f32x4*)&sC[buf][n];
#pragma unroll
            for (int i = 0; i < 4; ++i) { hs[n + i] = hs[n + i] * dA + xdt * Bv[i]; y += Cv[i] * hs[n + i]; } }
        y += dsk * xv;
        const float yz = y * zs;
        ACAT[row * ACAT_LD + 1024 + chx] = (bf16_t)f2bf(yz);
        const float ssq = wave_sum(yz * yz);
        if (p == 0) { SSQ[row * 64 + 2 * h] = ssq; SSQ[row * 64 + 2 * h + 1] = 0.f; }
    }
}
__global__ void __launch_bounds__(64) sgu_naive(const bf16_t* V, const float* VST, bf16_t* ACAT, const float* ln_w, const float* ln_b, const float* w_sp, const float* b_sp) {
    __shared__ float sv[CHUNK][64];
    __shared__ float smean[CHUNK], srstd[CHUNK];
    const int bc = blockIdx.x >> 4, g = (blockIdx.x >> 1) & 7, d = (blockIdx.x & 1) * 64 + threadIdx.x; const size_t row0 = (size_t)bc * CHUNK;
    for (int s = threadIdx.x; s < CHUNK; s += 64) { float su = 0.f, sq = 0.f;
        for (int j = 0; j < 16; ++j) { su += VST[((row0 + s) * 16 + j) * 2]; sq += VST[((row0 + s) * 16 + j) * 2 + 1]; }
        const float mu = su * (1.0f / D); const float var = fmaxf(sq * (1.0f / D) - mu * mu, 0.f); smean[s] = mu; srstd[s] = 1.0f / sqrtf(var + LN_EPS); }
    __syncthreads();
    const float lw = ln_w[g * NS + d], lb = ln_b[g * NS + d];
    for (int s = 0; s < CHUNK; ++s) sv[s][threadIdx.x] = (bf2f(V[(row0 + s) * D + g * NS + d]) - smean[s]) * srstd[s] * lw + lb;
    __syncthreads();
    for (int t = 0; t < CHUNK; ++t) { const float* wr = w_sp + ((size_t)g * CHUNK + t) * CHUNK; float mix = b_sp[g * CHUNK + t];
        for (int s = 0; s <= t; ++s) mix += wr[s] * sv[s][threadIdx.x];
        bf16_t* up = ACAT + (row0 + t) * ACAT_LD + 3072 + g * NS + d;
        *up = (bf16_t)f2bf(bf2f(*up) * mix); }
}

#ifndef DBG_STOP
#define DBG_STOP 0
#endif
#if DBG_STOP
__global__ void dbg_digest(const unsigned char* dout, float* dig, int which) {
    const int row = blockIdx.x * blockDim.x + threadIdx.x; if (row >= M) return; float s = 0.f;
    if (which == 1) { const bf16_t* V = (const bf16_t*)(dout + DO_V); const float* DT = (const float*)(dout + DO_DT); const float* VST = (const float*)(dout + DO_VST);
        for (int c = 0; c < D; ++c) s += bf2f(V[(size_t)row * D + c]); for (int c = 0; c < NH; ++c) s += DT[(size_t)row * NH + c]; for (int c = 0; c < 32; ++c) s += 1e-3f * VST[(size_t)row * 32 + c]; }
    else { const float* SSQ = (const float*)(dout + DO_SSQ); for (int c = 0; c < 64; ++c) s += SSQ[(size_t)row * 64 + c]; }
    dig[row] = s;
}
__global__ void dbg_dump(const unsigned char* ws, float* out, const float* dig, int which) {
    const size_t i = (size_t)blockIdx.x * blockDim.x + threadIdx.x; if (i >= (size_t)M * D) return; const size_t row = i / D; const int c = (int)(i % D); float v = 0.f;
    const bf16_t* XBC = (const bf16_t*)(ws + WS_XBC); const bf16_t* ACAT = (const bf16_t*)(ws + WS_ACAT);
    if (which == 1) { v = bf2f(XBC[row * XBCW + c]) + bf2f(XBC[row * XBCW + 1024 + c]) + bf2f(XBC[row * XBCW + 2048 + c]) + bf2f(ACAT[row * ACAT_LD + c]) + bf2f(ACAT[row * ACAT_LD + 1024 + c]) + bf2f(ACAT[row * ACAT_LD + 2048 + c]) + bf2f(ACAT[row * ACAT_LD + 3072 + c]) + dig[row]; }
    else if (which == 2) { v = bf2f(ACAT[row * ACAT_LD + 1024 + c]) + bf2f(ACAT[row * ACAT_LD + 2048 + c]) + bf2f(ACAT[row * ACAT_LD + 3072 + c]) + 1e-3f * dig[row]; }
    else if (which == 3) { v = bf2f(((const bf16_t*)(ws + WS_T))[i]); }
    else if (which == 4) { v = ((const float*)(ws + WS_H))[i] + bf2f(((const bf16_t*)(ws + WS_HB))[i]); }
    else if (which == 5) { const bf16_t* A = (const bf16_t*)(ws + WS_ACT); v = bf2f(A[row * FF + c]) + bf2f(A[row * FF + 1024 + c]) + bf2f(A[row * FF + 1792 + c]); }
    out[i] = v;
}
#endif

extern "C" void kernel_launch(void* const* d_in, const int* in_sizes, int n_in, void* d_out, int out_size, void* d_ws, size_t ws_size, hipStream_t stream) {
    static int grid = 0;
    if (grid == 0) {
        if (n_in != 23 || in_sizes[0] != M * D || out_size != M * D || ws_size < WS_END) { fprintf(stderr, "kernel_launch: unexpected shapes (n_in %d, in0 %d, out %d, ws %zu)\n", n_in, n_in > 0 ? in_sizes[0] : -1, out_size, ws_size); grid = -1; return; }
        int dev = 0, cus = 0, per_cu = 0;
        if (hipGetDevice(&dev) != hipSuccess || hipDeviceGetAttribute(&cus, hipDeviceAttributeMultiprocessorCount, dev) != hipSuccess) { grid = -1; return; }
        if (hipFuncSetAttribute((const void*)mk_fwd, hipFuncAttributeMaxDynamicSharedMemorySize, LDS_BYTES) != hipSuccess) { fprintf(stderr, "kernel_launch: hipFuncSetAttribute failed\n"); grid = -1; return; }
        if (hipOccupancyMaxActiveBlocksPerMultiprocessor(&per_cu, (const void*)mk_fwd, NWAVES * 64, LDS_BYTES) != hipSuccess || per_cu < 1) { fprintf(stderr, "kernel_launch: occupancy query says %d blocks per CU\n", per_cu); (void)hipGetLastError(); grid = -1; return; }
        grid = cus;
        if (grid != 256) fprintf(stderr, "kernel_launch: %d CUs (built for 256)\n", grid);
    }
    if (grid < 0) return;
    (void)hipMemsetAsync((char*)d_ws + WS_CTL, 0, CTL_ZERO_BYTES, stream);
    Args a{};
    for (int i = 0; i < 23; ++i) a.in[i] = (const float*)d_in[i];
    a.out = (float*)d_out; a.ws = (unsigned char*)d_ws;
    unsigned char* dout = (unsigned char*)d_out; unsigned char* ws = (unsigned char*)d_ws;
#if MK_N_LAUNCHES == 1
    a.ph_lo = 0; a.ph_hi = 8; a.li = 0;
    hipLaunchKernelGGL(mk_fwd, dim3(grid), dim3(NWAVES * 64), LDS_BYTES, stream, a);
#else
    for (int ph = 0; ph < 8; ++ph) {
        if (ph == 2) {
            hipLaunchKernelGGL(ssd_naive, dim3(BATCH * NH), dim3(64), 0, stream, (const bf16_t*)(ws + WS_XBC), (const float*)(dout + DO_DT), (bf16_t*)(ws + WS_ACAT), (float*)(dout + DO_SSQ),
                               (const float*)d_in[4], (const float*)d_in[5], (const float*)d_in[7], (const float*)d_in[8]);
            hipLaunchKernelGGL(sgu_naive, dim3(M / CHUNK * 16), dim3(64), 0, stream, (const bf16_t*)(dout + DO_V), (const float*)(dout + DO_VST), (bf16_t*)(ws + WS_ACAT),
                               (const float*)d_in[11], (const float*)d_in[12], (const float*)d_in[13], (const float*)d_in[14]);
#if DBG_STOP == 2
            { float* dig = (float*)(ws + WS_SS2); hipLaunchKernelGGL(dbg_digest, dim3(M / 256), dim3(256), 0, stream, (const unsigned char*)dout, dig, 2);
              hipLaunchKernelGGL(dbg_dump, dim3(M * D / 256), dim3(256), 0, stream, (const unsigned char*)ws, (float*)d_out, (const float*)dig, 2); break; }
#endif
            continue;
        }
        a.ph_lo = ph; a.ph_hi = ph + 1; a.li = ph;
        hipLaunchKernelGGL(mk_fwd, dim3(grid), dim3(NWAVES * 64), LDS_BYTES, stream, a);
#if DBG_STOP
        if (ph == DBG_STOP && DBG_STOP != 2) { float* dig = (float*)(ws + WS_SS2);
            if (DBG_STOP == 1) hipLaunchKernelGGL(dbg_digest, dim3(M / 256), dim3(256), 0, stream, (const unsigned char*)dout, dig, 1);
            hipLaunchKernelGGL(dbg_dump, dim3(M * D / 256), dim3(256), 0, stream, (const unsigned char*)ws, (float*)d_out, (const float*)dig, DBG_STOP); break; }
#endif
    }
#endif
}
```

```cpp
#include <hip/hip_runtime.h>
#include <cstdio>
#include <cstdint>

#ifndef NAIVE_P2
#define NAIVE_P2 0
#endif
#ifndef MK_N_LAUNCHES
#define MK_N_LAUNCHES 1
#endif

constexpr int D = 1024, SEQ = 4096, BATCH = 4, M = BATCH * SEQ;
constexpr int DI = 2048, NH = 32, HD = 64, NG = 4, NS = 128, XBCW = 3072, CHUNK = 128;
constexpr int N1 = 7168;
constexpr int FF = 2816;
constexpr int ACAT_LD = 4096;
constexpr int BCAT_LD = 5120;
constexpr float NORM_EPS = 1e-6f, LN_EPS = 1e-5f;

constexpr size_t MiB = 1u << 20;
constexpr size_t WS_CTL = 0, CTL_ZERO_BYTES = 64 * 1024;
constexpr size_t WS_BCAT = 1 * MiB, WS_WOUT = 11 * MiB, WS_WUP = 13 * MiB, WS_WDOWN = 24 * MiB;
constexpr size_t WS_SS2 = 29 * MiB + 512 * 1024, WS_SS3 = 30 * MiB + 512 * 1024;
constexpr size_t WS_ACAT = 32 * MiB, WS_XBC = 160 * MiB, WS_END = 256 * MiB;
constexpr size_t WS_T = 160 * MiB, WS_G = 192 * MiB, WS_H = 192 * MiB, WS_HB = 32 * MiB, WS_ACT = 64 * MiB;
constexpr size_t DO_CB = 32 * MiB;
constexpr size_t WS_WSB = 31 * MiB + 512 * 1024;
constexpr size_t DO_V = 0, DO_W1T = 32 * MiB, DO_DT = 48 * MiB, DO_ACUM = 50 * MiB, DO_SSQ = 52 * MiB, DO_HALO = 56 * MiB, DO_VST = 59 * MiB;

namespace pg8 {
#define PG8_LAS __attribute__((address_space(3)))
typedef unsigned short bf16_t;
typedef short bf16x8 __attribute__((ext_vector_type(8)));
typedef float f32x4 __attribute__((ext_vector_type(4)));
typedef float f32x2 __attribute__((ext_vector_type(2)));
typedef unsigned u32x4 __attribute__((ext_vector_type(4)));
typedef unsigned u32x2 __attribute__((ext_vector_type(2)));
constexpr int BM = 256, BK = 64, HALF = 128, HTB = HALF * BK * 2, STAGE_BYTES = 8 * HTB, NXCD = 8, WGM = 8;

__host__ __device__ __forceinline__ int lds_byte(int r, int c) { const int st = (r >> 4) * 2 + (c >> 5), rr = r & 15, cc = c & 31, ob = rr * 64 + cc * 2; return st * 1024 + (ob ^ (((ob >> 9) & 1) << 5)); }
__host__ __device__ __forceinline__ void stage_rc(int b, int& R, int& C) { const int st = b / 1024, sb = b % 1024, swz = sb ^ (((sb >> 9) & 1) << 5); R = (st >> 1) * 16 + swz / 64; C = (st & 1) * 32 + (swz % 64) / 2; }
__host__ __device__ __forceinline__ int perm32(int rho) { const int n = rho >> 4, i = rho & 15; return 8 * (i >> 2) + 4 * n + (i & 3); }

struct Unit { const char* A; const char* B; int nt, pm, pn, kind; };

__device__ __forceinline__ void tile_of(int L, int nM, int nN, int& pm, int& pn) {
    const int nwg = nM * nN; int wgid = L; { const int q = nwg / NXCD, r = nwg % NXCD, xcd = wgid % NXCD, off = wgid / NXCD; wgid = (xcd < r ? xcd * (q + 1) : r * (q + 1) + (xcd - r) * q) + off; }
    const int nig = WGM * nN, gid = wgid / nig, fm = gid * WGM, gsz = (nM - fm) < WGM ? (nM - fm) : WGM;
    pm = fm + ((wgid % nig) % gsz); pn = (wgid % nig) / gsz;
}

typedef __bf16 bf16x2_t __attribute__((ext_vector_type(2)));
__device__ __forceinline__ unsigned cvt_pk_bf16(float lo, float hi) { const f32x2 v = {lo, hi}; return __builtin_bit_cast(unsigned, __builtin_convertvector(v, bf16x2_t)); }
__device__ __forceinline__ float bf_lo(unsigned w) { return __builtin_bit_cast(float, w << 16); }
__device__ __forceinline__ float bf_hi(unsigned w) { return __builtin_bit_cast(float, w & 0xffff0000u); }
__device__ __forceinline__ float fast_sigmoid(float x) { return __builtin_amdgcn_rcpf(1.0f + __builtin_amdgcn_exp2f(-1.44269504089f * x)); }
__device__ __forceinline__ float fast_silu(float x) { return x * fast_sigmoid(x); }
__device__ __forceinline__ float gelu_tanh(float x) { const float u = 1.5957691216057308f * (x + 0.044715f * x * x * x); return x * fast_sigmoid(u); }

template <class Epi, class Sched, bool ALIGN_EPI, bool MAP62>
__device__ __forceinline__ void gemm_phase(PG8_LAS unsigned char* lds, const int lda, const int ldb, const Sched& S, const Epi& E) {
    const int tid = threadIdx.x, wid = __builtin_amdgcn_readfirstlane(tid >> 6), lane = tid & 63, wr = wid >> 2, wc = wid & 3, fr = lane & 15, fq = lane >> 4;
    unsigned voffA[2], voffB[2];
#pragma unroll
    for (int i = 0; i < 2; ++i) { int R, C; stage_rc(tid * 16 + i * 8192, R, C); const int Rb = Epi::PERM ? ((R & ~31) + perm32(R & 31)) : R; const int Ra = MAP62 ? (R - 2 * (R >> 6)) : R;
        voffA[i] = (unsigned)(Ra * lda + C) * 2u; voffB[i] = (unsigned)(Rb * ldb + C) * 2u; }
    const size_t kstep = (size_t)(BK * 2);
    const size_t hstepA = (size_t)(MAP62 ? 124 : 128) * lda * 2, hstepB = (size_t)HALF * ldb * 2;
    const unsigned ldsw = (unsigned)wid * 1024u;
    const int aoff = lds_byte(wr * 64 + fr, fq * 8), boff = lds_byte(wc * 32 + fr, fq * 8);
#define PG8_SA(b, h) (((b) * 2 + (h)) * HTB)
#define PG8_SB(b, h) ((4 + (b) * 2 + (h)) * HTB)
#define PG8_STAGE(bufoff, gbase, voff) do { _Pragma("unroll") for (int _i = 0; _i < 2; ++_i) \
        __builtin_amdgcn_global_load_lds((const unsigned*)((const char*)(gbase) + (voff)[_i]), (PG8_LAS unsigned*)(lds + (bufoff) + ldsw + _i * 8192), 16, 0, 0); } while (0)
#define PG8_LDA(dst, b, h) do { _Pragma("unroll") for (int m = 0; m < 4; ++m) _Pragma("unroll") for (int k = 0; k < 2; ++k) dst[m][k] = *(const PG8_LAS bf16x8*)(lds + PG8_SA(b, h) + aoff + m * 2048 + k * 1024); } while (0)
#define PG8_LDB(dst, b, h) do { _Pragma("unroll") for (int n = 0; n < 2; ++n) _Pragma("unroll") for (int k = 0; k < 2; ++k) dst[n][k] = *(const PG8_LAS bf16x8*)(lds + PG8_SB(b, h) + boff + n * 2048 + k * 1024); } while (0)
#define PG8_MMA(ai, bj, At, Bt) do { __builtin_amdgcn_s_setprio(1); _Pragma("unroll") for (int m = 0; m < 4; ++m) _Pragma("unroll") for (int n = 0; n < 2; ++n) _Pragma("unroll") for (int k = 0; k < 2; ++k) \
        acc[ai][bj][m][n] = __builtin_amdgcn_mfma_f32_16x16x32_bf16(Bt[n][k], At[m][k], acc[ai][bj][m][n], 0, 0, 0); __builtin_amdgcn_s_setprio(0); } while (0)
#define PG8_WAIT_V(n) asm volatile("s_waitcnt vmcnt(" #n ")" ::: "memory")
#define PG8_WAIT_L(n) asm volatile("s_waitcnt lgkmcnt(" #n ")" ::: "memory")
#define PG8_BAR __builtin_amdgcn_s_barrier()
#define PG8_SCHED __builtin_amdgcn_sched_barrier(0)
    Unit cur, nxt; int ui = 0;
    if (!S.next(0, cur)) return;
    f32x4 acc[2][2][4][2];
#pragma unroll
    for (int a = 0; a < 2; ++a)
#pragma unroll
        for (int b = 0; b < 2; ++b)
#pragma unroll
            for (int m = 0; m < 4; ++m)
#pragma unroll
                for (int n = 0; n < 2; ++n) acc[a][b][m][n] = (f32x4){0.f, 0.f, 0.f, 0.f};
    bf16x8 At[4][2], B0[2][2], B1[2][2];
    const char* cA = cur.A; const char* cB = cur.B;
    PG8_STAGE(PG8_SB(0, 0), cB, voffB); PG8_STAGE(PG8_SB(0, 1), cB + hstepB, voffB); PG8_STAGE(PG8_SA(0, 0), cA, voffA); PG8_STAGE(PG8_SA(0, 1), cA + hstepA, voffA);
    if (wr == 1) PG8_BAR;
    PG8_WAIT_V(2); PG8_BAR;
    PG8_STAGE(PG8_SB(1, 0), cB + kstep, voffB); PG8_STAGE(PG8_SA(1, 0), cA + kstep, voffA); PG8_STAGE(PG8_SB(1, 1), cB + hstepB + kstep, voffB);
    PG8_WAIT_V(6); PG8_BAR;
    for (;;) {
        const bool has_next = S.next(ui + 1, nxt);
        const char* nA = has_next ? nxt.A : cA; const char* nB = has_next ? nxt.B : cB;
        const int nt = cur.nt;
        for (int t = 0; t < nt; t += 2) {
            const bool last = (t == nt - 2);
            const char* a1 = cA + (size_t)(t + 1) * kstep;
            const char* a2 = last ? nA : cA + (size_t)(t + 2) * kstep; const char* b2 = last ? nB : cB + (size_t)(t + 2) * kstep;
            const char* a3 = a2 + kstep; const char* b3 = b2 + kstep;
            PG8_LDB(B0, 0, 0); PG8_LDB(B1, 0, 1); PG8_SCHED; PG8_LDA(At, 0, 0); PG8_STAGE(PG8_SA(1, 1), a1 + hstepA, voffA);
            PG8_WAIT_V(8); PG8_WAIT_L(0); PG8_BAR; PG8_MMA(0, 0, At, B0); PG8_MMA(0, 1, At, B1); PG8_BAR; PG8_SCHED;
            PG8_LDA(At, 0, 1); PG8_STAGE(PG8_SB(0, 0), b2, voffB); PG8_STAGE(PG8_SB(0, 1), b2 + hstepB, voffB); PG8_STAGE(PG8_SA(0, 0), a2, voffA);
            PG8_WAIT_V(8); PG8_WAIT_L(0); PG8_BAR; PG8_MMA(1, 0, At, B0); PG8_MMA(1, 1, At, B1); PG8_BAR; PG8_SCHED;
            PG8_LDB(B0, 1, 0); PG8_LDB(B1, 1, 1); PG8_SCHED; PG8_LDA(At, 1, 0); PG8_STAGE(PG8_SA(0, 1), a2 + hstepA, voffA);
            PG8_WAIT_V(8); PG8_WAIT_L(0); PG8_BAR; PG8_MMA(0, 0, At, B0); PG8_MMA(0, 1, At, B1); PG8_BAR; PG8_SCHED;
            PG8_LDA(At, 1, 1); PG8_STAGE(PG8_SB(1, 0), b3, voffB); PG8_STAGE(PG8_SB(1, 1), b3 + hstepB, voffB); PG8_STAGE(PG8_SA(1, 0), a3, voffA);
            PG8_WAIT_V(8); PG8_WAIT_L(0); PG8_BAR; PG8_MMA(1, 0, At, B0); PG8_MMA(1, 1, At, B1); PG8_BAR; PG8_SCHED;
        }
        if constexpr (ALIGN_EPI) { if (wr == 0) PG8_BAR; }
        E(acc, cur, wr, wc, fr, fq);
        if (!has_next) break;
#pragma unroll
        for (int a = 0; a < 2; ++a)
#pragma unroll
            for (int b = 0; b < 2; ++b)
#pragma unroll
                for (int m = 0; m < 4; ++m)
#pragma unroll
                    for (int n = 0; n < 2; ++n) acc[a][b][m][n] = (f32x4){0.f, 0.f, 0.f, 0.f};
        cur = nxt; cA = nA; cB = nB; ++ui;
        if constexpr (ALIGN_EPI) { if (wr == 1) PG8_BAR; }
    }
    PG8_WAIT_V(0);
    if constexpr (!ALIGN_EPI) { if (wr == 0) PG8_BAR; }
    PG8_BAR;
#undef PG8_SA
#undef PG8_SB
#undef PG8_STAGE
#undef PG8_LDA
#undef PG8_LDB
#undef PG8_MMA
#undef PG8_WAIT_V
#undef PG8_WAIT_L
#undef PG8_BAR
#undef PG8_SCHED
}
}

using pg8::bf16_t; using pg8::f32x4; using pg8::f32x2; using pg8::u32x4; using pg8::u32x2; using pg8::bf16x8; using pg8::Unit;
using pg8::cvt_pk_bf16; using pg8::bf_lo; using pg8::bf_hi; using pg8::fast_sigmoid; using pg8::fast_silu; using pg8::gelu_tanh;

constexpr int NWAVES = 8;
constexpr int RING_BYTES = 131072, LDSCTL_OFF = RING_BYTES, MISC_OFF = LDSCTL_OFF + 320, LDS_BYTES = 147456;
#define GAS __attribute__((address_space(1)))
#define LAS __attribute__((address_space(3)))
typedef GAS unsigned gu32;
#define RLX_AGENT __ATOMIC_RELAXED, __HIP_MEMORY_SCOPE_AGENT
#define LDS_WAIT() asm volatile("s_waitcnt lgkmcnt(0)" ::: "memory")
__device__ __forceinline__ unsigned f2bf(float f) { unsigned u = __builtin_bit_cast(unsigned, f); return (u + 0x7fffu + ((u >> 16) & 1u)) >> 16; }
__device__ __forceinline__ unsigned pk2(float lo, float hi) { return f2bf(lo) | (f2bf(hi) << 16); }
__device__ __forceinline__ float bf2f(bf16_t h) { return __builtin_bit_cast(float, (unsigned)h << 16); }
__device__ __forceinline__ float wave_sum(float v) {
#pragma unroll
    for (int o = 1; o < 64; o <<= 1) v += __shfl_xor(v, o);
    return v;
}

#define XB_TMO      128
#define XB_XCNT(j)  (256  + 64 * (j))
#define XB_XSUB(j)  (1280 + 64 * (j))
#define XB_XGEN(j)  (2304 + 64 * (j))
#define XB_TOP      3328
#define XB_TOPGEN   3392
#define XCD_BAR_WORDS 3456
#define XB_SPIN_CAP (1u << 20)
__device__ __forceinline__ unsigned xb_ld(unsigned* p)              { return __hip_atomic_load(p, __ATOMIC_RELAXED, __HIP_MEMORY_SCOPE_AGENT); }
__device__ __forceinline__ unsigned xb_add(unsigned* p, unsigned v) { return __hip_atomic_fetch_add(p, v, __ATOMIC_RELAXED, __HIP_MEMORY_SCOPE_AGENT); }
__device__ __forceinline__ unsigned xb_xcc_id() { return (unsigned)__builtin_amdgcn_s_getreg((3 << 11) | 20) & 0xFu; }
#define XB_SPIN(cond, bar) do { unsigned _sp = 0; while (cond) { __builtin_amdgcn_s_sleep(1); \
    if ((++_sp & 255u) == 0u) { if (xb_ld(&(bar)[XB_TMO])) break; if (_sp > XB_SPIN_CAP) { atomicAdd(&(bar)[XB_TMO], 1u); break; } } } } while (0)
struct XcdBarrier { unsigned* bar; unsigned x; volatile LAS unsigned* st; };
__device__ __forceinline__ XcdBarrier xcd_barrier_post(unsigned* bar, volatile LAS unsigned* st) {
    XcdBarrier b; b.bar = bar; b.x = xb_xcc_id(); b.st = st;
    if (threadIdx.x == 0) (void)xb_add(&bar[XB_XCNT(b.x)], 1u);
    return b;
}
__device__ __forceinline__ void xcd_barrier_complete(unsigned* bar, unsigned x, unsigned& nloc, unsigned& nx) {
    const unsigned G = gridDim.x * gridDim.y * gridDim.z;
    unsigned sum, cnt, mine, sp = 0u;
    for (;;) {
        sum = 0u; cnt = 0u; mine = 0u;
#pragma unroll
        for (unsigned j = 0; j < 16; ++j) { const unsigned c = xb_ld(&bar[XB_XCNT(j)]); sum += c; cnt += (c > 0u) ? 1u : 0u; mine = (j == x) ? c : mine; }
        if (sum == G) break;
        __builtin_amdgcn_s_sleep(1);
        if ((++sp & 255u) == 0u) { if (xb_ld(&bar[XB_TMO])) break; if (sp > XB_SPIN_CAP) { atomicAdd(&bar[XB_TMO], 1u); break; } }
    }
    nloc = mine > 0u ? mine : 1u; nx = cnt > 0u ? cnt : 1u;
}
__device__ __forceinline__ void xcd_barrier(const XcdBarrier& b) {
    asm volatile("s_waitcnt vmcnt(0)" ::: "memory");
    __syncthreads();
    if (threadIdx.x == 0) {
        unsigned* bar = b.bar;
        __builtin_amdgcn_s_waitcnt(0);
        unsigned nloc = b.st[0], nx = b.st[1];
        if (nloc == 0u) { xcd_barrier_complete(bar, b.x, nloc, nx); b.st[0] = nloc; b.st[1] = nx; }
        const unsigned old = xb_add(&bar[XB_XSUB(b.x)], 1u);
        const unsigned gen = old / nloc;
        if (old + 1u == (gen + 1u) * nloc) {
            __builtin_amdgcn_fence(__ATOMIC_RELEASE, "agent");
            asm volatile("s_waitcnt vmcnt(0)" ::: "memory");
            const unsigned og = xb_add(&bar[XB_TOP], 1u);
            const unsigned tg = og / nx;
            if (og + 1u == (tg + 1u) * nx) xb_add(&bar[XB_TOPGEN], 1u);
            else XB_SPIN(xb_ld(&bar[XB_TOPGEN]) == tg, bar);
            __builtin_amdgcn_fence(__ATOMIC_ACQUIRE, "agent");
            xb_add(&bar[XB_XGEN(b.x)], 1u);
            asm volatile("s_waitcnt vmcnt(0)" ::: "memory");
        } else {
            XB_SPIN(xb_ld(&bar[XB_XGEN(b.x)]) == gen, bar);
            __builtin_amdgcn_fence(__ATOMIC_ACQUIRE, "agent");
            asm volatile("s_waitcnt vmcnt(0)" ::: "memory");
        }
    }
    __syncthreads();
}

struct Frame {
    LAS unsigned char* lds; volatile LAS unsigned* MISC; gu32* ctl;
    int tid, lane, wave, vcu, G;
    const float* in[23]; float* out; unsigned char* ws;
};
constexpr int CW_BAR = 4096;

__device__ __forceinline__ void p0_transpose_item(const float* W, int ldw, int k0, int c0, const float* sc, bf16_t* WT, int ldt, int n0, int kd0, LAS float* scr, int lane) {
#pragma unroll 8
    for (int i = 0; i < 32; ++i) { const int kk = 2 * i + (lane >> 5); const float s = sc ? sc[k0 + kk] : 1.0f; scr[kk * 33 + (lane & 31)] = W[(size_t)(k0 + kk) * ldw + c0 + (lane & 31)] * s; }
    LDS_WAIT(); asm volatile("" ::: "memory");
    const int c = lane & 7;
#pragma unroll
    for (int j = 0; j < 4; ++j) { const int n = (lane >> 3) + 8 * j; const LAS float* s = scr + (8 * c) * 33 + n;
        u32x4 o; o.x = pk2(s[0 * 33], s[1 * 33]); o.y = pk2(s[2 * 33], s[3 * 33]); o.z = pk2(s[4 * 33], s[5 * 33]); o.w = pk2(s[6 * 33], s[7 * 33]);
        *(u32x4*)(WT + (size_t)(n0 + n) * ldt + kd0 + 8 * c) = o; }
    LDS_WAIT(); asm volatile("" ::: "memory");
}
__device__ __forceinline__ void p0_prologue(Frame& F) {
    LAS float* scr = (LAS float*)(F.lds + F.wave * 16384);
    const int gw = F.vcu * NWAVES + F.wave, NGW = F.G * NWAVES, lane = F.lane;
    const float* norm1_w = F.in[1]; const float* w_in = F.in[2]; const float* ssd_norm_w = F.in[9]; const float* w_branch = F.in[15];
    const float* w_out = F.in[16]; const float* norm2_w = F.in[17]; const float* w_up = F.in[18]; const float* w_down = F.in[21];
    bf16_t* W1t = (bf16_t*)((unsigned char*)F.out + DO_W1T); bf16_t* Bcat = (bf16_t*)(F.ws + WS_BCAT); bf16_t* Woutt = (bf16_t*)(F.ws + WS_WOUT);
    bf16_t* Wupt = (bf16_t*)(F.ws + WS_WUP); bf16_t* Wdownt = (bf16_t*)(F.ws + WS_WDOWN);
    constexpr int I_W1 = 16 * 225, I_GA = 16 * 32, I_PA = 32 * 32, I_PB = 16 * 32, I_GB = 16 * 32, I_WO = 16 * 32, I_UP = 16 * 176, I_DN = 44 * 32;
    constexpr int NITEMS = I_W1 + I_GA + I_PA + I_PB + I_GB + I_WO + I_UP + I_DN;
    for (int it = gw; it < NITEMS; it += NGW) {
        int r = it;
        if (r < I_W1) { const int kb = r / 225, nb = r % 225, n = 32 * nb; const int c = n < 5120 ? n : (n < 7168 ? n + 32 : n - 2048);
            p0_transpose_item(w_in, 9248, 64 * kb, c, norm1_w, W1t, D, n, 64 * kb, scr, lane); continue; } r -= I_W1;
        if (r < I_GA) { const int kb = r / 32, nb = r % 32; p0_transpose_item(w_in, 9248, 64 * kb, 7200 + 32 * nb, norm1_w, Bcat, BCAT_LD, 32 * nb, 64 * kb, scr, lane); continue; } r -= I_GA;
        if (r < I_PA) { const int kb = r / 32, nb = r % 32; p0_transpose_item(w_branch, D, 64 * kb, 32 * nb, ssd_norm_w, Bcat, BCAT_LD, 32 * nb, 1024 + 64 * kb, scr, lane); continue; } r -= I_PA;
        if (r < I_PB) { const int kb = r / 32, nb = r % 32; p0_transpose_item(w_branch + (size_t)DI * D, D, 64 * kb, 32 * nb, nullptr, Bcat, BCAT_LD, 32 * nb, 3072 + 64 * kb, scr, lane); continue; } r -= I_PB;
        if (r < I_GB) { const int kb = r / 32, nb = r % 32; p0_transpose_item(w_in, 9248, 64 * kb, 8224 + 32 * nb, norm1_w, Bcat, BCAT_LD, 32 * nb, 4096 + 64 * kb, scr, lane); continue; } r -= I_GB;
        if (r < I_WO) { const int kb = r / 32, nb = r % 32; p0_transpose_item(w_out, D, 64 * kb, 32 * nb, nullptr, Woutt, D, 32 * nb, 64 * kb, scr, lane); continue; } r -= I_WO;
        if (r < I_UP) { const int kb = r / 176, nb = r % 176, n = 32 * nb, j = n >> 8, w = n & 255; const int c = w < 128 ? 128 * j + w : FF + 128 * j + (w - 128);
            p0_transpose_item(w_up, 2 * FF, 64 * kb, c, norm2_w, Wupt, D, n, 64 * kb, scr, lane); continue; } r -= I_UP;
        { const int kb = r / 32, nb = r % 32; p0_transpose_item(w_down, D, 64 * kb, 32 * nb, nullptr, Wdownt, FF, 32 * nb, 64 * kb, scr, lane); }
    }
    { const float* wsp = F.in[13]; bf16_t* Wsb = (bf16_t*)(F.ws + WS_WSB);
        for (int i = (int)blockIdx.x * 512 + F.tid; i < 8 * CHUNK * CHUNK; i += F.G * 512) { const int t = (i >> 7) & 127, sidx = i & 127; Wsb[i] = (bf16_t)f2bf(sidx <= t ? wsp[i] : 0.f); } }
    const float* x = F.in[0]; bf16_t* ACAT = (bf16_t*)(F.ws + WS_ACAT);
    for (int m = gw; m < M; m += NGW) {
        const GAS f32x4* xr = (const GAS f32x4*)(x + (size_t)m * D) + lane;
        f32x4 v[4]; float s = 0.f;
#pragma unroll
        for (int j = 0; j < 4; ++j) { v[j] = xr[64 * j]; s += (v[j].x * v[j].x + v[j].y * v[j].y) + (v[j].z * v[j].z + v[j].w * v[j].w); }
        const float rstd = 1.f / sqrtf(wave_sum(s) * (1.f / D) + NORM_EPS);
        GAS unsigned long long* o8 = (GAS unsigned long long*)(ACAT + (size_t)m * ACAT_LD) + lane;
#pragma unroll
        for (int j = 0; j < 4; ++j) o8[64 * j] = (unsigned long long)pk2(v[j].x * rstd, v[j].y * rstd) | ((unsigned long long)pk2(v[j].z * rstd, v[j].w * rstd) << 32);
    }
}

struct SchedP1 {
    const char* A; const char* B; int G, c;
    __device__ __forceinline__ bool next(int i, Unit& u) const {
        const int L = i * G + c; if (L >= 64 * 28) return false;
        pg8::tile_of(L, 64, 28, u.pm, u.pn); u.nt = D / 64; u.kind = 0;
        u.A = A + (size_t)u.pm * 256 * ACAT_LD * 2; u.B = B + (size_t)u.pn * 256 * D * 2; return true;
    }
};
struct EpiP1 {
    static constexpr bool PERM = true;
    bf16_t* ACAT; bf16_t* XBC; bf16_t* V; bf16_t* HALO; float* VST; const float* uv_b;
    __device__ __forceinline__ void operator()(const f32x4 (&acc)[2][2][4][2], const Unit& u, int wr, int wc, int fr, int fq) const {
        const int row0 = u.pm * 256 + wr * 64 + fr, ct = u.pn * 256 + wc * 32 + 8 * fq;
        if (u.pn < 8) {
#pragma unroll
            for (int ai = 0; ai < 2; ++ai)
#pragma unroll
                for (int m = 0; m < 4; ++m) { const int r = row0 + ai * 128 + m * 16;
#pragma unroll
                    for (int bj = 0; bj < 2; ++bj) { const f32x4 v0 = acc[ai][bj][m][0], v1 = acc[ai][bj][m][1]; u32x4 w;
                        w.x = cvt_pk_bf16(fast_silu(v0[0]), fast_silu(v0[1])); w.y = cvt_pk_bf16(fast_silu(v0[2]), fast_silu(v0[3]));
                        w.z = cvt_pk_bf16(fast_silu(v1[0]), fast_silu(v1[1])); w.w = cvt_pk_bf16(fast_silu(v1[2]), fast_silu(v1[3]));
                        *(u32x4*)(ACAT + (size_t)r * ACAT_LD + 1024 + ct + bj * 128) = w; } }
        } else if (u.pn < 20) {
#pragma unroll
            for (int ai = 0; ai < 2; ++ai)
#pragma unroll
                for (int m = 0; m < 4; ++m) { const int r = row0 + ai * 128 + m * 16;
#pragma unroll
                    for (int bj = 0; bj < 2; ++bj) { const f32x4 v0 = acc[ai][bj][m][0], v1 = acc[ai][bj][m][1]; u32x4 w;
                        w.x = cvt_pk_bf16(v0[0], v0[1]); w.y = cvt_pk_bf16(v0[2], v0[3]); w.z = cvt_pk_bf16(v1[0], v1[1]); w.w = cvt_pk_bf16(v1[2], v1[3]);
                        const int c = ct + bj * 128 - 2048;
                        *(u32x4*)(XBC + (size_t)r * XBCW + c) = w;
                        if ((r & 127) >= 125) *(u32x4*)(HALO + (size_t)((r >> 7) * 3 + (r & 127) - 125) * XBCW + c) = w; } }
        } else {
            const bool isv = u.pn >= 24;
#pragma unroll
            for (int ai = 0; ai < 2; ++ai)
#pragma unroll
                for (int m = 0; m < 4; ++m) { const int r = row0 + ai * 128 + m * 16; float s = 0.f, q = 0.f;
#pragma unroll
                    for (int bj = 0; bj < 2; ++bj) { const int c = ct + bj * 128 - 5120;
                        const f32x4 b0 = *(const f32x4*)(uv_b + c), b1 = *(const f32x4*)(uv_b + c + 4);
                        f32x4 v0 = acc[ai][bj][m][0] + b0, v1 = acc[ai][bj][m][1] + b1;
#pragma unroll
                        for (int i = 0; i < 4; ++i) { v0[i] = gelu_tanh(v0[i]); v1[i] = gelu_tanh(v1[i]); s += v0[i] + v1[i]; q += v0[i] * v0[i] + v1[i] * v1[i]; }
                        u32x4 w; w.x = cvt_pk_bf16(v0[0], v0[1]); w.y = cvt_pk_bf16(v0[2], v0[3]); w.z = cvt_pk_bf16(v1[0], v1[1]); w.w = cvt_pk_bf16(v1[2], v1[3]);
                        if (!isv) *(u32x4*)(ACAT + (size_t)r * ACAT_LD + 3072 + c) = w; else *(u32x4*)(V + (size_t)r * D + (c - 1024)) = w; }
                    if (isv) { s += __shfl_xor(s, 16); s += __shfl_xor(s, 32); q += __shfl_xor(q, 16); q += __shfl_xor(q, 32);
                        if (fq == 0) *(f32x2*)(VST + ((size_t)r * 16 + (u.pn - 24) * 4 + wc) * 2) = (f32x2){s, q}; } }
        }
    }
};
__device__ __forceinline__ void p1_dt(Frame& F) {
    const bf16_t* XN = (const bf16_t*)(F.ws + WS_ACAT); const bf16_t* Wdt = (const bf16_t*)((unsigned char*)F.out + DO_W1T) + (size_t)N1 * D;
    float* DT = (float*)((unsigned char*)F.out + DO_DT); const float* dt_bias = F.in[6];
    const int gw = F.vcu * NWAVES + F.wave, NGW = F.G * NWAVES, fr = F.lane & 15, fq = F.lane >> 4;
    for (int item = gw; item < 2048; item += NGW) { const int rb = item >> 1, nb = item & 1;
        f32x4 acc = (f32x4){0.f, 0.f, 0.f, 0.f};
        const bf16_t* ap = XN + (size_t)(rb * 16 + fr) * ACAT_LD + fq * 8; const bf16_t* bp = Wdt + (size_t)(nb * 16 + fr) * D + fq * 8;
#pragma unroll 4
        for (int ks = 0; ks < 32; ++ks) { const bf16x8 a = *(const bf16x8*)(ap + ks * 32), b = *(const bf16x8*)(bp + ks * 32); acc = __builtin_amdgcn_mfma_f32_16x16x32_bf16(a, b, acc, 0, 0, 0); }
        const float bias = dt_bias[nb * 16 + fr];
#pragma unroll
        for (int j = 0; j < 4; ++j) { const float v = acc[j] + bias; const float sp = fmaxf(v, 0.f) + log1pf(expf(-fabsf(v))); DT[(size_t)(rb * 16 + 4 * fq + j) * NH + nb * 16 + fr] = sp; }
    }
}

__device__ __forceinline__ void p2_ssd_naive(Frame& F, int b, int h) {
    const bf16_t* XBC = (const bf16_t*)(F.ws + WS_XBC); const float* DT = (const float*)((unsigned char*)F.out + DO_DT); bf16_t* ACAT = (bf16_t*)(F.ws + WS_ACAT); float* SSQ = (float*)((unsigned char*)F.out + DO_SSQ);
    const float* conv_w = F.in[4]; const float* conv_b = F.in[5]; const float* a_log = F.in[7]; const float* d_skip = F.in[8];
    LAS float* sB = (LAS float*)F.lds; LAS float* sC = sB + 2 * NS;
    const int g = h >> 3, p = F.lane;
    const float a = -expf(a_log[h]), dsk = d_skip[h];
    const int chx = h * HD + p;
    int ch[4]; ch[0] = DI + g * NS + p; ch[1] = ch[0] + 64; ch[2] = DI + NG * NS + g * NS + p; ch[3] = ch[2] + 64;
    float wx[4], wq[4][4]; const float bx = conv_b[chx]; float bq[4];
#pragma unroll
    for (int k = 0; k < 4; ++k) wx[k] = conv_w[k * XBCW + chx];
#pragma unroll
    for (int j = 0; j < 4; ++j) { bq[j] = conv_b[ch[j]];
#pragma unroll
        for (int k = 0; k < 4; ++k) wq[j][k] = conv_w[k * XBCW + ch[j]]; }
    float hs[NS];
#pragma unroll
    for (int n = 0; n < NS; ++n) hs[n] = 0.f;
    float xh[3] = {0.f, 0.f, 0.f}, qh[4][3];
#pragma unroll
    for (int j = 0; j < 4; ++j) { qh[j][0] = 0.f; qh[j][1] = 0.f; qh[j][2] = 0.f; }
    size_t row = (size_t)b * SEQ;
    bf16_t nx = XBC[row * XBCW + chx], nq[4];
#pragma unroll
    for (int j = 0; j < 4; ++j) nq[j] = XBC[row * XBCW + ch[j]];
    float ndt = DT[row * NH + h]; bf16_t nz = ACAT[row * ACAT_LD + 1024 + chx];
    for (int t = 0; t < SEQ; ++t) {
        row = (size_t)b * SEQ + t;
        const float xc = bf2f(nx); float qc[4];
#pragma unroll
        for (int j = 0; j < 4; ++j) qc[j] = bf2f(nq[j]);
        const float dt = ndt; const float zs = bf2f(nz);
        if (t + 1 < SEQ) { const size_t r1 = row + 1; nx = XBC[r1 * XBCW + chx];
#pragma unroll
            for (int j = 0; j < 4; ++j) nq[j] = XBC[r1 * XBCW + ch[j]];
            ndt = DT[r1 * NH + h]; nz = ACAT[r1 * ACAT_LD + 1024 + chx]; }
        const float xv = fast_silu(bx + wx[0] * xh[0] + wx[1] * xh[1] + wx[2] * xh[2] + wx[3] * xc);
        xh[0] = xh[1]; xh[1] = xh[2]; xh[2] = xc;
        const int buf = (t & 1) * NS;
#pragma unroll
        for (int j = 0; j < 4; ++j) { const float v = fast_silu(bq[j] + wq[j][0] * qh[j][0] + wq[j][1] * qh[j][1] + wq[j][2] * qh[j][2] + wq[j][3] * qc[j]);
            qh[j][0] = qh[j][1]; qh[j][1] = qh[j][2]; qh[j][2] = qc[j];
            if (j < 2) sB[buf + p + 64 * j] = v; else sC[buf + p + 64 * (j - 2)] = v; }
        LDS_WAIT(); asm volatile("" ::: "memory");
        const float dA = expf(dt * a), xdt = xv * dt; float y = 0.f;
#pragma unroll
        for (int n = 0; n < NS; n += 4) { const f32x4 Bv = *(const LAS f32x4*)&sB[buf + n], Cv = *(const LAS f32x4*)&sC[buf + n];
#pragma unroll
            for (int i = 0; i < 4; ++i) { hs[n + i] = hs[n + i] * dA + xdt * Bv[i]; y += Cv[i] * hs[n + i]; } }
        y += dsk * xv;
        const float yz = y * zs;
        ACAT[row * ACAT_LD + 1024 + chx] = (bf16_t)f2bf(yz);
        const float ssq = wave_sum(yz * yz);
        if (p == 0) { SSQ[row * 64 + 2 * h] = ssq; SSQ[row * 64 + 2 * h + 1] = 0.f; }
    }
}
__device__ __forceinline__ void p2_sgu_naive(Frame& F, int item, LAS float* sv, LAS float* sst) {
    const bf16_t* V = (const bf16_t*)((unsigned char*)F.out + DO_V); const float* VST = (const float*)((unsigned char*)F.out + DO_VST); bf16_t* ACAT = (bf16_t*)(F.ws + WS_ACAT);
    const float* ln_w = F.in[11]; const float* ln_b = F.in[12]; const float* w_sp = F.in[13]; const float* b_sp = F.in[14];
    const int bc = item >> 5, g = (item >> 2) & 7, qd = item & 3, dl = F.lane & 31, th = F.lane >> 5, d = qd * 32 + dl; const size_t row0 = (size_t)bc * CHUNK;
    for (int s = F.lane; s < CHUNK; s += 64) { float su = 0.f, sq = 0.f;
        for (int j = 0; j < 16; ++j) { su += VST[((row0 + s) * 16 + j) * 2]; sq += VST[((row0 + s) * 16 + j) * 2 + 1]; }
        const float mu = su * (1.0f / D); const float var = fmaxf(sq * (1.0f / D) - mu * mu, 0.f); sst[2 * s] = mu; sst[2 * s + 1] = 1.0f / sqrtf(var + LN_EPS); }
    LDS_WAIT(); asm volatile("" ::: "memory");
    const float lw = ln_w[g * NS + d], lb = ln_b[g * NS + d];
    for (int s = th; s < CHUNK; s += 2) sv[s * 32 + dl] = (bf2f(V[(row0 + s) * D + g * NS + d]) - sst[2 * s]) * sst[2 * s + 1] * lw + lb;
    LDS_WAIT(); asm volatile("" ::: "memory");
    for (int t = th; t < CHUNK; t += 2) { const float* wr = w_sp + ((size_t)g * CHUNK + t) * CHUNK; float mix = b_sp[g * CHUNK + t];
        for (int s = 0; s <= t; ++s) mix += wr[s] * sv[s * 32 + dl];
        bf16_t* up = ACAT + (row0 + t) * ACAT_LD + 3072 + g * NS + d;
        *up = (bf16_t)f2bf(bf2f(*up) * mix); }
    LDS_WAIT(); asm volatile("" ::: "memory");
}
__device__ __forceinline__ void p2_naive(Frame& F) {
    if (blockIdx.x < BATCH * NH) { if (F.wave == 0) p2_ssd_naive(F, (int)blockIdx.x >> 5, (int)blockIdx.x & 31); }
    else { const int wv = ((int)blockIdx.x - BATCH * NH) * NWAVES + F.wave, nwv = (F.G - BATCH * NH) * NWAVES;
        LAS float* sv = (LAS float*)(F.lds + F.wave * 16384); LAS float* sst = (LAS float*)(F.lds + MISC_OFF + 128 + F.wave * 1024);
        for (int item = wv; item < (M / CHUNK) * 32; item += nwv) p2_sgu_naive(F, item, sv, sst); }
}

__device__ __forceinline__ int swz128(int row, int chunk) { return row * 256 + ((chunk ^ (row & 15)) << 4); }
__device__ __forceinline__ float fast_exp(float x) { return __builtin_amdgcn_exp2f(1.44269504089f * x); }
__device__ __forceinline__ void unpack8(const u32x4 w, float (&f)[8]) { f[0] = bf_lo(w.x); f[1] = bf_hi(w.x); f[2] = bf_lo(w.y); f[3] = bf_hi(w.y); f[4] = bf_lo(w.z); f[5] = bf_hi(w.z); f[6] = bf_lo(w.w); f[7] = bf_hi(w.w); }
__device__ __forceinline__ u32x4 pack8(const float (&f)[8]) { u32x4 w; w.x = cvt_pk_bf16(f[0], f[1]); w.y = cvt_pk_bf16(f[2], f[3]); w.z = cvt_pk_bf16(f[4], f[5]); w.w = cvt_pk_bf16(f[6], f[7]); return w; }
#define MFMA16(a, b, c) __builtin_amdgcn_mfma_f32_16x16x32_bf16(__builtin_bit_cast(bf16x8, a), __builtin_bit_cast(bf16x8, b), c, 0, 0, 0)

__device__ __forceinline__ void p2a_bc_item(Frame& F, int item) {
    const int bc = item >> 2, g = item & 3, c = bc & 31, tid = F.tid, lane = F.lane, w = F.wave, fr = lane & 15, fq = lane >> 4; const size_t row0 = (size_t)bc * CHUNK;
    bf16_t* XBC = (bf16_t*)(F.ws + WS_XBC); const bf16_t* HALO = (const bf16_t*)((unsigned char*)F.out + DO_HALO); const float* conv_w = F.in[4]; const float* conv_b = F.in[5];
    LAS unsigned char* Bl = F.lds; LAS unsigned char* Cl = F.lds + 32768;
#pragma unroll 2
    for (int k = 0; k < 8; ++k) { const int idx = tid + 512 * k, mat = idx >> 11, rem = idx & 2047, s = rem >> 4, ch = rem & 15; const int col = DI + mat * 512 + g * NS + ch * 8;
        float a[8];
        { const f32x4 b0 = *(const f32x4*)(conv_b + col), b1 = *(const f32x4*)(conv_b + col + 4); a[0] = b0[0]; a[1] = b0[1]; a[2] = b0[2]; a[3] = b0[3]; a[4] = b1[0]; a[5] = b1[1]; a[6] = b1[2]; a[7] = b1[3]; }
#pragma unroll
        for (int j = 0; j < 4; ++j) { const int rr = s - 3 + j; u32x4 rw = (u32x4){0u, 0u, 0u, 0u};
            if (rr >= 0) rw = *(const u32x4*)(XBC + (row0 + rr) * XBCW + col); else if (c > 0) rw = *(const u32x4*)(HALO + (size_t)((bc - 1) * 3 + rr + 3) * XBCW + col);
            float x[8]; unpack8(rw, x); const f32x4 w0 = *(const f32x4*)(conv_w + j * XBCW + col), w1 = *(const f32x4*)(conv_w + j * XBCW + col + 4);
#pragma unroll
            for (int i = 0; i < 4; ++i) { a[i] += w0[i] * x[i]; a[4 + i] += w1[i] * x[4 + i]; } }
#pragma unroll
        for (int i = 0; i < 8; ++i) a[i] = fast_silu(a[i]);
        *(LAS u32x4*)((mat ? Cl : Bl) + swz128(s, ch)) = pack8(a); }
    __syncthreads();
#pragma unroll
    for (int k = 0; k < 4; ++k) { const int idx = tid + 512 * k, s = idx >> 4, ch = idx & 15;
        *(u32x4*)(XBC + (row0 + s) * XBCW + DI + 512 + g * NS + ch * 8) = *(const LAS u32x4*)(Cl + swz128(s, ch));
        const int n = s, sc = ch; unsigned short e[8];
#pragma unroll
        for (int j = 0; j < 8; ++j) e[j] = *(const LAS unsigned short*)(Bl + swz128(8 * sc + j, n >> 3) + (n & 7) * 2);
        u32x4 o; o.x = e[0] | ((unsigned)e[1] << 16); o.y = e[2] | ((unsigned)e[3] << 16); o.z = e[4] | ((unsigned)e[5] << 16); o.w = e[6] | ((unsigned)e[7] << 16);
        *(u32x4*)(XBC + (row0 + n) * XBCW + DI + g * NS + sc * 8) = o; }
    { bf16_t* CB = (bf16_t*)((unsigned char*)F.out + DO_CB) + (size_t)item * CHUNK * CHUNK;
        u32x4 cf[4];
#pragma unroll
        for (int ks = 0; ks < 4; ++ks) cf[ks] = *(const LAS u32x4*)(Cl + swz128(16 * w + fr, 4 * ks + fq));
        for (int sb = 0; sb <= (w | 1); ++sb) { f32x4 acc = (f32x4){0.f, 0.f, 0.f, 0.f};
#pragma unroll
            for (int ks = 0; ks < 4; ++ks) { const u32x4 af = *(const LAS u32x4*)(Bl + swz128(16 * sb + fr, 4 * ks + fq)); acc = MFMA16(af, cf[ks], acc); }
            u32x2 o; o.x = cvt_pk_bf16(acc[0], acc[1]); o.y = cvt_pk_bf16(acc[2], acc[3]);
            *(u32x2*)(CB + (size_t)(16 * w + fr) * CHUNK + 16 * sb + 4 * fq) = o; } }
    { const int h = 8 * g + w; const float* DT = (const float*)((unsigned char*)F.out + DO_DT); float* AC = (float*)((unsigned char*)F.out + DO_ACUM); const float ah = -expf(F.in[7][h]);
        const float v0 = DT[(row0 + 2 * lane) * NH + h] * ah, v1 = v0 + DT[(row0 + 2 * lane + 1) * NH + h] * ah; float sc = v1;
#pragma unroll
        for (int o = 1; o < 64; o <<= 1) { const float t = __shfl_up(sc, o); if (lane >= o) sc += t; }
        const float ex = sc - v1; AC[(row0 + 2 * lane) * NH + h] = ex + v0; AC[(row0 + 2 * lane + 1) * NH + h] = ex + v1; }
    __syncthreads();
}
__device__ __forceinline__ void p2a_sgu_item(Frame& F, int item) {
    const int bc = item >> 3, g = item & 7, tid = F.tid, lane = F.lane, w = F.wave, fr = lane & 15, fq = lane >> 4; const size_t row0 = (size_t)bc * CHUNK;
    const bf16_t* V = (const bf16_t*)((unsigned char*)F.out + DO_V); const float* VST = (const float*)((unsigned char*)F.out + DO_VST); bf16_t* ACAT = (bf16_t*)(F.ws + WS_ACAT);
    const bf16_t* Wsb = (const bf16_t*)(F.ws + WS_WSB) + (size_t)g * CHUNK * CHUNK; const float* ln_w = F.in[11] + g * NS; const float* ln_b = F.in[12] + g * NS; const float* b_sp = F.in[14] + g * CHUNK;
    LAS unsigned char* LT = F.lds; LAS float* st = (LAS float*)(F.lds + 32768);
    if (tid < CHUNK) { const float* p = VST + (row0 + tid) * 32; float su = 0.f, sq = 0.f;
#pragma unroll
        for (int j = 0; j < 8; ++j) { const f32x4 q = *(const f32x4*)(p + 4 * j); su += q[0] + q[2]; sq += q[1] + q[3]; }
        const float mu = su * (1.0f / D), var = fmaxf(sq * (1.0f / D) - mu * mu, 0.f); st[2 * tid] = mu; st[2 * tid + 1] = 1.0f / sqrtf(var + LN_EPS); }
    __syncthreads();
#pragma unroll
    for (int k = 0; k < 4; ++k) { const int idx = tid + 512 * k, s = idx >> 4, ch = idx & 15;
        float x[8]; unpack8(*(const u32x4*)(V + (row0 + s) * D + g * NS + ch * 8), x); const float mu = st[2 * s], rs = st[2 * s + 1];
        const f32x4 w0 = *(const f32x4*)(ln_w + ch * 8), w1 = *(const f32x4*)(ln_w + ch * 8 + 4), b0 = *(const f32x4*)(ln_b + ch * 8), b1 = *(const f32x4*)(ln_b + ch * 8 + 4);
#pragma unroll
        for (int i = 0; i < 8; ++i) { const float y = (x[i] - mu) * rs * (i < 4 ? w0[i] : w1[i - 4]) + (i < 4 ? b0[i] : b1[i - 4]); const int d = ch * 8 + i;
            *(LAS unsigned short*)(LT + swz128(d, s >> 3) + (s & 7) * 2) = (unsigned short)f2bf(y); } }
    __syncthreads();
    f32x4 acc[8];
#pragma unroll
    for (int db = 0; db < 8; ++db) acc[db] = (f32x4){0.f, 0.f, 0.f, 0.f};
    const int kmax = (16 * w + 15) >> 5;
    for (int ks = 0; ks <= kmax; ++ks) { const u32x4 wf = *(const u32x4*)(Wsb + (size_t)(16 * w + fr) * CHUNK + 32 * ks + 8 * fq);
#pragma unroll
        for (int db = 0; db < 8; ++db) { const u32x4 af = *(const LAS u32x4*)(LT + swz128(16 * db + fr, 4 * ks + fq)); acc[db] = MFMA16(af, wf, acc[db]); } }
    const int t = 16 * w + fr; const float bs = b_sp[t];
#pragma unroll
    for (int db = 0; db < 8; ++db) { bf16_t* up = ACAT + (row0 + t) * ACAT_LD + 3072 + g * NS + 16 * db + 4 * fq; const u32x2 u = *(const u32x2*)up; u32x2 o;
        o.x = cvt_pk_bf16(bf_lo(u.x) * (acc[db][0] + bs), bf_hi(u.x) * (acc[db][1] + bs)); o.y = cvt_pk_bf16(bf_lo(u.y) * (acc[db][2] + bs), bf_hi(u.y) * (acc[db][3] + bs)); *(u32x2*)up = o; }
    __syncthreads();
}
__device__ __forceinline__ void p2a_phase(Frame& F) {
    for (int it = (int)blockIdx.x; it < 512; it += F.G) p2a_bc_item(F, it);
    for (int it = (int)blockIdx.x; it < 1024; it += F.G) p2a_sgu_item(F, it);
}
constexpr int P2B_XT = 0, P2B_XS = 8704, P2B_SL = 17408, P2B_XF = 26112, P2B_AC = 44544, P2B_BUF = 45056, P2B_PITCH = 272;
__device__ __forceinline__ void p2b_chain(Frame& F) {
    const int id = F.vcu; if (id >= 256) return;
    const int b = id >> 6, g = (id >> 4) & 3, h = 8 * g + ((id >> 1) & 7), ph = id & 1, tid = F.tid, lane = F.lane, w = F.wave, fr = lane & 15, fq = lane >> 4;
    const bf16_t* XBC = (const bf16_t*)(F.ws + WS_XBC); bf16_t* ACAT = (bf16_t*)(F.ws + WS_ACAT); unsigned char* dout = (unsigned char*)F.out;
    const float* DT = (const float*)(dout + DO_DT); const float* ACg = (const float*)(dout + DO_ACUM); float* SSQ = (float*)(dout + DO_SSQ); const bf16_t* CBg = (const bf16_t*)(dout + DO_CB);
    const float dsk = F.in[8][h];
    const int sl = tid >> 2, pc = tid & 3, xcol = h * HD + ph * 32 + 8 * pc;
    float cw[4][8], cbias[8];
    { const float* conv_w = F.in[4]; const float* conv_b = F.in[5];
#pragma unroll
        for (int i = 0; i < 8; ++i) { cbias[i] = conv_b[xcol + i];
#pragma unroll
            for (int j = 0; j < 4; ++j) cw[j][i] = conv_w[j * XBCW + xcol + i]; } }
    f32x4 st[2] = {(f32x4){0.f, 0.f, 0.f, 0.f}, (f32x4){0.f, 0.f, 0.f, 0.f}};
    for (int i = tid; i < 8704 / 4; i += 512) ((LAS unsigned*)(F.lds + P2B_SL))[i] = 0u;
    const int lcol = 16 * w + fr;
    for (int c = 0; c < 32; ++c) {
        LAS unsigned char* L = F.lds + (c & 1) * P2B_BUF; LAS unsigned char* Ln = F.lds + ((c + 1) & 1) * P2B_BUF;
        const int bc = b * 32 + c; const size_t row0 = (size_t)bc * CHUNK;
        { float a[8];
#pragma unroll
            for (int i = 0; i < 8; ++i) a[i] = cbias[i];
#pragma unroll
            for (int j = 0; j < 4; ++j) { const int rr = sl - 3 + j; u32x4 rw = (u32x4){0u, 0u, 0u, 0u};
                if (rr >= 0 || c > 0) rw = *(const u32x4*)(XBC + (size_t)((long)row0 + rr) * XBCW + xcol);
                float x[8]; unpack8(rw, x);
#pragma unroll
                for (int i = 0; i < 8; ++i) a[i] += cw[j][i] * x[i]; }
            const float dt = DT[(row0 + sl) * NH + h], ac = ACg[(row0 + sl) * NH + h], atot = ACg[(row0 + CHUNK - 1) * NH + h]; const float de = fast_exp(atot - ac);
#pragma unroll
            for (int i = 0; i < 8; ++i) { a[i] = fast_silu(a[i]); const float xd = a[i] * dt; const int p = 8 * pc + i;
                *(LAS unsigned short*)(L + P2B_XT + p * P2B_PITCH + sl * 2) = (unsigned short)f2bf(xd);
                *(LAS unsigned short*)(L + P2B_XS + p * P2B_PITCH + sl * 2) = (unsigned short)f2bf(xd * de); }
            *(LAS f32x4*)(L + P2B_XF + (sl * 36 + 8 * pc) * 4) = (f32x4){a[0], a[1], a[2], a[3]}; *(LAS f32x4*)(L + P2B_XF + (sl * 36 + 8 * pc + 4) * 4) = (f32x4){a[4], a[5], a[6], a[7]};
            if (pc == 0) *(LAS float*)(L + P2B_AC + sl * 4) = ac; }
        __syncthreads();
        const float acme = *(const LAS float*)(L + P2B_AC + lcol * 4), atot = *(const LAS float*)(L + P2B_AC + 127 * 4);
        const float el = fast_exp(acme), eA = fast_exp(atot);
        f32x4 ad[2] = {(f32x4){0.f, 0.f, 0.f, 0.f}, (f32x4){0.f, 0.f, 0.f, 0.f}}, ao[2] = {(f32x4){0.f, 0.f, 0.f, 0.f}, (f32x4){0.f, 0.f, 0.f, 0.f}};
        st[0] = st[0] * eA; st[1] = st[1] * eA;
        const int kmax = (16 * w + 15) >> 5;
        const bf16_t* cbrow = CBg + ((size_t)(bc * 4 + g) * CHUNK + lcol) * CHUNK; const bf16_t* crow = XBC + (row0 + lcol) * XBCW + DI + 512 + g * NS; const bf16_t* btrow = XBC + (row0 + lcol) * XBCW + DI + g * NS;
#pragma unroll
        for (int ks = 0; ks < 4; ++ks) { const int ko = 32 * ks + 8 * fq;
            if (ks <= kmax) { float m[8]; unpack8(*(const u32x4*)(cbrow + ko), m); const f32x4 a0 = *(const LAS f32x4*)(L + P2B_AC + ko * 4), a1 = *(const LAS f32x4*)(L + P2B_AC + ko * 4 + 16);
#pragma unroll
                for (int j = 0; j < 8; ++j) { const float as = j < 4 ? a0[j] : a1[j - 4]; const float dcy = fast_exp(acme - as); m[j] = (ko + j <= lcol) ? m[j] * dcy : 0.f; }
                const u32x4 mf = pack8(m);
#pragma unroll
                for (int pb = 0; pb < 2; ++pb) { const u32x4 af = *(const LAS u32x4*)(L + P2B_XT + (16 * pb + fr) * P2B_PITCH + ko * 2); ad[pb] = MFMA16(af, mf, ad[pb]); } }
            const u32x4 cfr = *(const u32x4*)(crow + ko), bfr = *(const u32x4*)(btrow + ko);
#pragma unroll
            for (int pb = 0; pb < 2; ++pb) { const u32x4 sf = *(const LAS u32x4*)(L + P2B_SL + (16 * pb + fr) * P2B_PITCH + ko * 2); ao[pb] = MFMA16(sf, cfr, ao[pb]);
                const u32x4 xf = *(const LAS u32x4*)(L + P2B_XS + (16 * pb + fr) * P2B_PITCH + ko * 2); st[pb] = MFMA16(xf, bfr, st[pb]); } }
        float ssq = 0.f;
#pragma unroll
        for (int pb = 0; pb < 2; ++pb) { bf16_t* zp = ACAT + (row0 + lcol) * ACAT_LD + 1024 + h * HD + ph * 32 + 16 * pb + 4 * fq; const u32x2 zz = *(const u32x2*)zp;
            const f32x4 xf = *(const LAS f32x4*)(L + P2B_XF + (lcol * 36 + 16 * pb + 4 * fq) * 4);
            const f32x4 y = ad[pb] + ao[pb] * el + xf * dsk; const float y0 = y[0] * bf_lo(zz.x), y1 = y[1] * bf_hi(zz.x), y2 = y[2] * bf_lo(zz.y), y3 = y[3] * bf_hi(zz.y);
            ssq += (y0 * y0 + y1 * y1) + (y2 * y2 + y3 * y3); u32x2 o; o.x = cvt_pk_bf16(y0, y1); o.y = cvt_pk_bf16(y2, y3); *(u32x2*)zp = o; }
        ssq += __shfl_xor(ssq, 16); ssq += __shfl_xor(ssq, 32);
        if (fq == 0) SSQ[(row0 + lcol) * 64 + 2 * h + ph] = ssq;
#pragma unroll
        for (int pb = 0; pb < 2; ++pb)
#pragma unroll
            for (int r = 0; r < 4; ++r) *(LAS unsigned short*)(Ln + P2B_SL + (16 * pb + 4 * fq + r) * P2B_PITCH + lcol * 2) = (unsigned short)f2bf(st[pb][r]);
    }
    __syncthreads();
}

struct SchedP3 {
    const char* A; const char* B; int pm, pn;
    __device__ __forceinline__ bool next(int i, Unit& u) const {
        if (i >= 4) return false;
        u.pm = pm; u.pn = pn; u.kind = i;
        const int acol = (i == 1) ? 1024 : (i == 3 ? 3072 : 0), bcol = (i == 0) ? 0 : (i == 1 ? 1024 : (i == 2 ? 4096 : 3072));
        u.nt = (i == 1) ? 32 : 16;
        u.A = A + ((size_t)pm * 256 * ACAT_LD + acol) * 2; u.B = B + ((size_t)pn * 256 * BCAT_LD + bcol) * 2; return true;
    }
};
struct EpiP3 {
    static constexpr bool PERM = true;
    bf16_t* G; bf16_t* T; const float* b_gate; const float* SSQ;
    __device__ __forceinline__ void operator()(const f32x4 (&acc)[2][2][4][2], const Unit& u, int wr, int wc, int fr, int fq) const {
        const int row0 = u.pm * 256 + wr * 64 + fr, ct = u.pn * 256 + wc * 32 + 8 * fq;
        if (u.kind == 0 || u.kind == 2) {
            const float* bg = b_gate + (u.kind == 2 ? 1024 : 0);
#pragma unroll
            for (int bj = 0; bj < 2; ++bj) { const int c = ct + bj * 128; const f32x4 b0 = *(const f32x4*)(bg + c), b1 = *(const f32x4*)(bg + c + 4);
#pragma unroll
                for (int ai = 0; ai < 2; ++ai)
#pragma unroll
                    for (int m = 0; m < 4; ++m) { const int r = row0 + ai * 128 + m * 16; const f32x4 v0 = acc[ai][bj][m][0] + b0, v1 = acc[ai][bj][m][1] + b1; u32x4 w;
                        w.x = cvt_pk_bf16(fast_sigmoid(v0[0]), fast_sigmoid(v0[1])); w.y = cvt_pk_bf16(fast_sigmoid(v0[2]), fast_sigmoid(v0[3]));
                        w.z = cvt_pk_bf16(fast_sigmoid(v1[0]), fast_sigmoid(v1[1])); w.w = cvt_pk_bf16(fast_sigmoid(v1[2]), fast_sigmoid(v1[3]));
                        *(u32x4*)(G + (size_t)r * D + c) = w; } }
        } else if (u.kind == 1) {
#pragma unroll
            for (int ai = 0; ai < 2; ++ai)
#pragma unroll
                for (int m = 0; m < 4; ++m) { const int r = row0 + ai * 128 + m * 16;
                    float ss = 0.f;
#pragma unroll
                    for (int j = 0; j < 4; ++j) { const f32x4 p = *(const f32x4*)(SSQ + (size_t)r * 64 + fq * 16 + j * 4); ss += (p[0] + p[1]) + (p[2] + p[3]); }
                    ss += __shfl_xor(ss, 16); ss += __shfl_xor(ss, 32);
                    const float rs = 1.0f / sqrtf(ss * (1.0f / DI) + NORM_EPS);
#pragma unroll
                    for (int bj = 0; bj < 2; ++bj) { const int c = ct + bj * 128; const u32x4 g = *(const u32x4*)(G + (size_t)r * D + c); const f32x4 v0 = acc[ai][bj][m][0] * rs, v1 = acc[ai][bj][m][1] * rs; u32x4 w;
                        w.x = cvt_pk_bf16(bf_lo(g.x) * v0[0], bf_hi(g.x) * v0[1]); w.y = cvt_pk_bf16(bf_lo(g.y) * v0[2], bf_hi(g.y) * v0[3]);
                        w.z = cvt_pk_bf16(bf_lo(g.z) * v1[0], bf_hi(g.z) * v1[1]); w.w = cvt_pk_bf16(bf_lo(g.w) * v1[2], bf_hi(g.w) * v1[3]);
                        *(u32x4*)(T + (size_t)r * D + c) = w; } }
        } else {
#pragma unroll
            for (int ai = 0; ai < 2; ++ai)
#pragma unroll
                for (int m = 0; m < 4; ++m) { const int r = row0 + ai * 128 + m * 16;
#pragma unroll
                    for (int bj = 0; bj < 2; ++bj) { const int c = ct + bj * 128; const u32x4 g = *(const u32x4*)(G + (size_t)r * D + c); const u32x4 t = *(const u32x4*)(T + (size_t)r * D + c);
                        const f32x4 v0 = acc[ai][bj][m][0], v1 = acc[ai][bj][m][1]; u32x4 w;
                        w.x = cvt_pk_bf16(bf_lo(t.x) + bf_lo(g.x) * v0[0], bf_hi(t.x) + bf_hi(g.x) * v0[1]); w.y = cvt_pk_bf16(bf_lo(t.y) + bf_lo(g.y) * v0[2], bf_hi(t.y) + bf_hi(g.y) * v0[3]);
                        w.z = cvt_pk_bf16(bf_lo(t.z) + bf_lo(g.z) * v1[0], bf_hi(t.z) + bf_hi(g.z) * v1[1]); w.w = cvt_pk_bf16(bf_lo(t.w) + bf_lo(g.w) * v1[2], bf_hi(t.w) + bf_hi(g.w) * v1[3]);
                        *(u32x4*)(T + (size_t)r * D + c) = w; } }
        }
    }
};

struct SchedSq {
    const char* A; const char* B; int lda, K, c;
    __device__ __forceinline__ bool next(int i, Unit& u) const {
        if (i >= 1 || c >= 256) return false;
        pg8::tile_of(c, 64, 4, u.pm, u.pn); u.nt = K / 64; u.kind = 0;
        u.A = A + (size_t)u.pm * 256 * lda * 2; u.B = B + (size_t)u.pn * 256 * K * 2; return true;
    }
};
template <bool WRITE_BF16> struct EpiRes {
    static constexpr bool PERM = false;
    const float* base; float* out; bf16_t* ob; float* SS;
    __device__ __forceinline__ void operator()(const f32x4 (&acc)[2][2][4][2], const Unit& u, int wr, int wc, int fr, int fq) const {
        const int row0 = u.pm * 256 + wr * 64 + fr, col0 = u.pn * 256 + wc * 32 + 4 * fq;
#pragma unroll
        for (int ai = 0; ai < 2; ++ai)
#pragma unroll
            for (int m = 0; m < 4; ++m) { const int r = row0 + ai * 128 + m * 16; const size_t off = (size_t)r * D + col0; float q = 0.f;
#pragma unroll
                for (int bj = 0; bj < 2; ++bj)
#pragma unroll
                    for (int n = 0; n < 2; ++n) { const size_t o = off + bj * 128 + n * 16; const f32x4 h = *(const f32x4*)(base + o) + acc[ai][bj][m][n];
                        *(f32x4*)(out + o) = h; q += (h[0] * h[0] + h[1] * h[1]) + (h[2] * h[2] + h[3] * h[3]);
                        if (WRITE_BF16) { u32x2 w; w.x = cvt_pk_bf16(h[0], h[1]); w.y = cvt_pk_bf16(h[2], h[3]); *(u32x2*)(ob + o) = w; } }
                q += __shfl_xor(q, 16); q += __shfl_xor(q, 32);
                if (fq == 0) SS[(size_t)r * 16 + u.pn * 4 + wc] = q; }
    }
};

struct SchedP5 {
    const char* A; const char* B; int G, c;
    __device__ __forceinline__ bool next(int i, Unit& u) const {
        const int L = i * G + c; if (L >= 68 * 22) return false;
        pg8::tile_of(L, 68, 22, u.pm, u.pn); u.nt = D / 64;
        const int q = u.pm / 17, ii = u.pm % 17, o = ii < 16 ? 248 * ii : SEQ - 248;
        u.kind = q * SEQ + o;
        u.A = A + ((long)u.kind - 2) * (long)(D * 2); u.B = B + (size_t)u.pn * 256 * D * 2; return true;
    }
};
template <int CTRL> __device__ __forceinline__ float dpp_keep(float oldv, float x) { return __builtin_bit_cast(float, __builtin_amdgcn_update_dpp(__builtin_bit_cast(int, oldv), __builtin_bit_cast(int, x), CTRL, 0xf, 0xf, false)); }
struct EpiP5 {
    static constexpr bool PERM = true;
    bf16_t* ACT; const float* SS2; const float* cw; const float* cb;
    __device__ __forceinline__ void operator()(f32x4 (&acc)[2][2][4][2], const Unit& u, int wr, int wc, int fr, int fq) const {
        const int tok0 = u.kind, ii = u.pm % 17; const int skip = ii < 16 ? 0 : 120; const bool first = (ii == 0);
        const int j0 = u.pn * 128 + wc * 32 + 8 * fq;
#pragma unroll
        for (int ai = 0; ai < 2; ++ai)
#pragma unroll
            for (int m = 0; m < 4; ++m) { const int blk = 2 * ai + wr, lr = 16 * m + fr; const int tok = tok0 + 62 * blk + lr - 2;
                const bool zero = first && blk == 0 && lr < 2;
                const int tokc = zero ? tok0 : tok;
                const f32x4 p = *(const f32x4*)(SS2 + (size_t)tokc * 16 + 4 * fq); float ss = (p[0] + p[1]) + (p[2] + p[3]);
                ss += __shfl_xor(ss, 16); ss += __shfl_xor(ss, 32);
                const float rs = 1.0f / sqrtf(ss * (1.0f / D) + NORM_EPS);
#pragma unroll
                for (int bj = 0; bj < 2; ++bj)
#pragma unroll
                    for (int n = 0; n < 2; ++n) acc[ai][bj][m][n] = zero ? (f32x4){0.f, 0.f, 0.f, 0.f} : acc[ai][bj][m][n] * rs; }
#pragma unroll
        for (int n = 0; n < 2; ++n) {
            f32x4 w0[2], w1[2], w2[2], bb[2];
#pragma unroll
            for (int bj = 0; bj < 2; ++bj) { const int ch = bj * FF + j0 + 4 * n; w0[bj] = *(const f32x4*)(cw + ch); w1[bj] = *(const f32x4*)(cw + 2 * FF + ch); w2[bj] = *(const f32x4*)(cw + 4 * FF + ch); bb[bj] = *(const f32x4*)(cb + ch); }
#pragma unroll
            for (int ai = 0; ai < 2; ++ai) { const int blk = 2 * ai + wr;
#pragma unroll
                for (int m = 3; m >= 0; --m) {
                    f32x4 cv[2];
#pragma unroll
                    for (int bj = 0; bj < 2; ++bj) {
#pragma unroll
                        for (int i = 0; i < 4; ++i) { const float x = acc[ai][bj][m][n][i]; const float xp = m > 0 ? acc[ai][bj][m - 1][n][i] : 0.f;
                            const float s1 = dpp_keep<0x111>(dpp_keep<0x121>(0.f, xp), x);
                            const float s2 = dpp_keep<0x112>(dpp_keep<0x122>(0.f, xp), x);
                            cv[bj][i] = bb[bj][i] + w2[bj][i] * x + w1[bj][i] * s1 + w0[bj][i] * s2; } }
                    const int lr = 16 * m + fr, oi = 62 * blk + lr - 2;
                    u32x2 w; w.x = cvt_pk_bf16(fast_silu(cv[0][0]) * cv[1][0], fast_silu(cv[0][1]) * cv[1][1]); w.y = cvt_pk_bf16(fast_silu(cv[0][2]) * cv[1][2], fast_silu(cv[0][3]) * cv[1][3]);
                    if (lr >= 2 && oi >= skip) *(u32x2*)(ACT + (size_t)(tok0 + oi) * FF + j0 + 4 * n) = w;
                    asm volatile("" ::: "memory");
                }
            }
        }
    }
};

__device__ __forceinline__ void p7_final(Frame& F) {
    const float* SS3 = (const float*)(F.ws + WS_SS3); const float* fw = F.in[22];
    const int gw = F.vcu * NWAVES + F.wave, NGW = F.G * NWAVES, lane = F.lane;
    f32x4 wv[4];
#pragma unroll
    for (int j = 0; j < 4; ++j) wv[j] = *((const f32x4*)fw + lane + 64 * j);
    for (int m = gw; m < M; m += NGW) {
        float ss = lane < 16 ? SS3[(size_t)m * 16 + lane] : 0.f; ss = wave_sum(ss);
        const float rs = 1.0f / sqrtf(ss * (1.0f / D) + NORM_EPS);
        GAS f32x4* o = (GAS f32x4*)(F.out + (size_t)m * D) + lane;
#pragma unroll
        for (int j = 0; j < 4; ++j) { f32x4 v = o[64 * j]; v = v * rs * wv[j]; o[64 * j] = v; }
    }
}

struct Args { const float* in[23]; float* out; unsigned char* ws; int ph_lo, ph_hi, li, pad; };
__global__ void __launch_bounds__(NWAVES * 64, 2) mk_fwd(Args args) {
    extern __shared__ __attribute__((aligned(16))) unsigned char lds[];
    Frame F;
    F.lds = (LAS unsigned char*)lds; F.MISC = (volatile LAS unsigned*)(F.lds + MISC_OFF);
    F.tid = threadIdx.x; F.lane = F.tid & 63; F.wave = __builtin_amdgcn_readfirstlane(F.tid >> 6);
    F.G = gridDim.x; { const int bx = blockIdx.x; F.vcu = (F.G % 8 == 0) ? (bx % 8) * (F.G / 8) + bx / 8 : bx; }
#pragma unroll
    for (int i = 0; i < 23; ++i) F.in[i] = args.in[i];
    F.out = args.out; F.ws = args.ws; F.ctl = (gu32*)(args.ws + WS_CTL);
    for (int u = F.tid; u < (LDS_BYTES - LDSCTL_OFF) / 4; u += NWAVES * 64) ((LAS unsigned*)(F.lds + LDSCTL_OFF))[u] = 0u;
    __syncthreads();
    XcdBarrier bar; bar.bar = (unsigned*)(F.ctl + CW_BAR); bar.x = 0; bar.st = nullptr;
    if (MK_N_LAUNCHES == 1) bar = xcd_barrier_post((unsigned*)(F.ctl + CW_BAR), F.MISC + 8);
#define GRID_BAR() do { if (MK_N_LAUNCHES == 1) xcd_barrier(bar); } while (0)
    const int lo = args.ph_lo, hi = args.ph_hi;
#ifndef PH_MASK
#define PH_MASK 0xff
#endif
#define IN(k) (((PH_MASK >> (k)) & 1) && lo <= (k) && (k) < hi)
    unsigned char* dout = (unsigned char*)F.out;

    if (IN(0)) { p0_prologue(F); GRID_BAR(); }
    if (IN(1)) {
        SchedP1 S{(const char*)(F.ws + WS_ACAT), (const char*)(dout + DO_W1T), F.G, (int)blockIdx.x};
        EpiP1 E{(bf16_t*)(F.ws + WS_ACAT), (bf16_t*)(F.ws + WS_XBC), (bf16_t*)(dout + DO_V), (bf16_t*)(dout + DO_HALO), (float*)(dout + DO_VST), F.in[10]};
        pg8::gemm_phase<EpiP1, SchedP1, true, false>(F.lds, ACAT_LD, D, S, E);
        p1_dt(F);
        GRID_BAR();
    }
#if NAIVE_P2
    if (IN(2)) { p2_naive(F); GRID_BAR(); }
#else
    if (IN(2)) { p2a_phase(F); GRID_BAR(); p2b_chain(F); GRID_BAR(); }
#endif
    if (IN(3)) {
        int pm, pn; pg8::tile_of((int)blockIdx.x, 64, 4, pm, pn);
        SchedP3 S{(const char*)(F.ws + WS_ACAT), (const char*)(F.ws + WS_BCAT), pm, pn};
        EpiP3 E{(bf16_t*)(F.ws + WS_G), (bf16_t*)(F.ws + WS_T), F.in[3], (const float*)(dout + DO_SSQ)};
        if (blockIdx.x < 256) pg8::gemm_phase<EpiP3, SchedP3, true, false>(F.lds, ACAT_LD, BCAT_LD, S, E);
        GRID_BAR();
    }
    if (IN(4)) {
        SchedSq S{(const char*)(F.ws + WS_T), (const char*)(F.ws + WS_WOUT), D, D, (int)blockIdx.x};
        EpiRes<true> E{F.in[0], (float*)(F.ws + WS_H), (bf16_t*)(F.ws + WS_HB), (float*)(F.ws + WS_SS2)};
        pg8::gemm_phase<EpiRes<true>, SchedSq, true, false>(F.lds, D, D, S, E);
        GRID_BAR();
    }
    if (IN(5)) {
        SchedP5 S{(const char*)(F.ws + WS_HB), (const char*)(F.ws + WS_WUP), F.G, (int)blockIdx.x};
        EpiP5 E{(bf16_t*)(F.ws + WS_ACT), (const float*)(F.ws + WS_SS2), F.in[19], F.in[20]};
        pg8::gemm_phase<EpiP5, SchedP5, true, true>(F.lds, D, D, S, E);
        GRID_BAR();
    }
    if (IN(6)) {
        SchedSq S{(const char*)(F.ws + WS_ACT), (const char*)(F.ws + WS_WDOWN), FF, FF, (int)blockIdx.x};
        EpiRes<false> E{(const float*)(F.ws + WS_H), F.out, nullptr, (float*)(F.ws + WS_SS3)};
        pg8::gemm_phase<EpiRes<false>, SchedSq, true, false>(F.lds, FF, FF, S, E);
        GRID_BAR();
    }
    if (IN(7)) p7_final(F);
#undef IN
#undef GRID_BAR
}

__global__ void __launch_bounds__(64) ssd_naive(const bf16_t* XBC, const float* DT, bf16_t* ACAT, float* SSQ,
                                               const float* conv_w, const float* conv_b, const float* a_log, const float* d_skip) {
    __shared__ float sB[2][NS], sC[2][NS];
    const int b = blockIdx.x >> 5, h = blockIdx.x & 31, g = h >> 3, p = threadIdx.x;
    const float a = -expf(a_log[h]), dsk = d_skip[h];
    const int chx = h * HD + p;
    int ch[4]; ch[0] = DI + g * NS + p; ch[1] = ch[0] + 64; ch[2] = DI + NG * NS + g * NS + p; ch[3] = ch[2] + 64;
    float wx[4], wq[4][4]; const float bx = conv_b[chx]; float bq[4];
#pragma unroll
    for (int k = 0; k < 4; ++k) wx[k] = conv_w[k * XBCW + chx];
#pragma unroll
    for (int j = 0; j < 4; ++j) { bq[j] = conv_b[ch[j]];
#pragma unroll
        for (int k = 0; k < 4; ++k) wq[j][k] = conv_w[k * XBCW + ch[j]]; }
    float hs[NS];
#pragma unroll
    for (int n = 0; n < NS; ++n) hs[n] = 0.f;
    float xh[3] = {0.f, 0.f, 0.f}, qh[4][3];
#pragma unroll
    for (int j = 0; j < 4; ++j) { qh[j][0] = 0.f; qh[j][1] = 0.f; qh[j][2] = 0.f; }
    size_t row = (size_t)b * SEQ;
    bf16_t nx = XBC[row * XBCW + chx], nq[4];
#pragma unroll
    for (int j = 0; j < 4; ++j) nq[j] = XBC[row * XBCW + ch[j]];
    float ndt = DT[row * NH + h]; bf16_t nz = ACAT[row * ACAT_LD + 1024 + chx];
    for (int t = 0; t < SEQ; ++t) {
        row = (size_t)b * SEQ + t;
        const float xc = bf2f(nx); float qc[4];
#pragma unroll
        for (int j = 0; j < 4; ++j) qc[j] = bf2f(nq[j]);
        const float dt = ndt; const float zs = bf2f(nz);
        if (t + 1 < SEQ) { const size_t r1 = row + 1; nx = XBC[r1 * XBCW + chx];
#pragma unroll
            for (int j = 0; j < 4; ++j) nq[j] = XBC[r1 * XBCW + ch[j]];
            ndt = DT[r1 * NH + h]; nz = ACAT[r1 * ACAT_LD + 1024 + chx]; }
        const float xv = fast_silu(bx + wx[0] * xh[0] + wx[1] * xh[1] + wx[2] * xh[2] + wx[3] * xc);
        xh[0] = xh[1]; xh[1] = xh[2]; xh[2] = xc;
        const int buf = t & 1;
#pragma unroll
        for (int j = 0; j < 4; ++j) { const float v = fast_silu(bq[j] + wq[j][0] * qh[j][0] + wq[j][1] * qh[j][1] + wq[j][2] * qh[j][2] + wq[j][3] * qc[j]);
            qh[j][0] = qh[j][1]; qh[j][1] = qh[j][2]; qh[j][2] = qc[j];
            if (j < 2) sB[buf][p + 64 * j] = v; else sC[buf][p + 64 * (j - 2)] = v; }
        __syncthreads();
        const float dA = expf(dt * a), xdt = xv * dt; float y = 0.f;
#pragma unroll
        for (int n = 0; n < NS; n += 4) { const f32x4 Bv = *(const f32x4*)&sB[buf][n], Cv = *(const f32x4*)&sC[buf][n];
#pragma unroll
            for (int i = 0; i < 4; ++i) { hs[n + i] = hs[n + i] * dA + xdt * Bv[i]; y += Cv[i] * hs[n + i]; } }
        y += dsk * xv;
        const float yz = y * zs;
        ACAT[row * ACAT_LD + 1024 + chx] = (bf16_t)f2bf(yz);
        const float ssq = wave_sum(yz * yz);
        if (p == 0) { SSQ[row * 64 + 2 * h] = ssq; SSQ[row * 64 + 2 * h + 1] = 0.f; }
    }
}
__global__ void __launch_bounds__(64) sgu_naive(const bf16_t* V, const float* VST, bf16_t* ACAT, const float* ln_w, const float* ln_b, const float* w_sp, const float* b_sp) {
    __shared__ float sv[CHUNK][64];
    __shared__ float smean[CHUNK], srstd[CHUNK];
    const int bc = blockIdx.x >> 4, g = (blockIdx.x >> 1) & 7, d = (blockIdx.x & 1) * 64 + threadIdx.x; const size_t row0 = (size_t)bc * CHUNK;
    for (int s = threadIdx.x; s < CHUNK; s += 64) { float su = 0.f, sq = 0.f;
        for (int j = 0; j < 16; ++j) { su += VST[((row0 + s) * 16 + j) * 2]; sq += VST[((row0 + s) * 16 + j) * 2 + 1]; }
        const float mu = su * (1.0f / D); const float var = fmaxf(sq * (1.0f / D) - mu * mu, 0.f); smean[s] = mu; srstd[s] = 1.0f / sqrtf(var + LN_EPS); }
    __syncthreads();
    const float lw = ln_w[g * NS + d], lb = ln_b[g * NS + d];
    for (int s = 0; s < CHUNK; ++s) sv[s][threadIdx.x] = (bf2f(V[(row0 + s) * D + g * NS + d]) - smean[s]) * srstd[s] * lw + lb;
    __syncthreads();
    for (int t = 0; t < CHUNK; ++t) { const float* wr = w_sp + ((size_t)g * CHUNK + t) * CHUNK; float mix = b_sp[g * CHUNK + t];
        for (int s = 0; s <= t; ++s) mix += wr[s] * sv[s][threadIdx.x];
        bf16_t* up = ACAT + (row0 + t) * ACAT_LD + 3072 + g * NS + d;
        *up = (bf16_t)f2bf(bf2f(*up) * mix); }
}

#ifndef DBG_STOP
#define DBG_STOP 0
#endif
#if DBG_STOP
__global__ void dbg_digest(const unsigned char* dout, float* dig, int which) {
    const int row = blockIdx.x * blockDim.x + threadIdx.x; if (row >= M) return; float s = 0.f;
    if (which == 1) { const bf16_t* V = (const bf16_t*)(dout + DO_V); const float* DT = (const float*)(dout + DO_DT); const float* VST = (const float*)(dout + DO_VST);
        for (int c = 0; c < D; ++c) s += bf2f(V[(size_t)row * D + c]); for (int c = 0; c < NH; ++c) s += DT[(size_t)row * NH + c]; for (int c = 0; c < 32; ++c) s += 1e-3f * VST[(size_t)row * 32 + c]; }
    else { const float* SSQ = (const float*)(dout + DO_SSQ); for (int c = 0; c < 64; ++c) s += SSQ[(size_t)row * 64 + c]; }
    dig[row] = s;
}
__global__ void dbg_dump(const unsigned char* ws, float* out, const float* dig, int which) {
    const size_t i = (size_t)blockIdx.x * blockDim.x + threadIdx.x; if (i >= (size_t)M * D) return; const size_t row = i / D; const int c = (int)(i % D); float v = 0.f;
    const bf16_t* XBC = (const bf16_t*)(ws + WS_XBC); const bf16_t* ACAT = (const bf16_t*)(ws + WS_ACAT);
    if (which == 1) { v = bf2f(XBC[row * XBCW + c]) + bf2f(XBC[row * XBCW + 1024 + c]) + bf2f(XBC[row * XBCW + 2048 + c]) + bf2f(ACAT[row * ACAT_LD + c]) + bf2f(ACAT[row * ACAT_LD + 1024 + c]) + bf2f(ACAT[row * ACAT_LD + 2048 + c]) + bf2f(ACAT[row * ACAT_LD + 3072 + c]) + dig[row]; }
    else if (which == 2) { v = bf2f(ACAT[row * ACAT_LD + 1024 + c]) + bf2f(ACAT[row * ACAT_LD + 2048 + c]) + bf2f(ACAT[row * ACAT_LD + 3072 + c]) + 1e-3f * dig[row]; }
    else if (which == 3) { v = bf2f(((const bf16_t*)(ws + WS_T))[i]); }
    else if (which == 4) { v = ((const float*)(ws + WS_H))[i] + bf2f(((const bf16_t*)(ws + WS_HB))[i]); }
    else if (which == 5) { const bf16_t* A = (const bf16_t*)(ws + WS_ACT); v = bf2f(A[row * FF + c]) + bf2f(A[row * FF + 1024 + c]) + bf2f(A[row * FF + 1792 + c]); }
    out[i] = v;
}
#endif

extern "C" void kernel_launch(void* const* d_in, const int* in_sizes, int n_in, void* d_out, int out_size, void* d_ws, size_t ws_size, hipStream_t stream) {
    static int grid = 0;
    if (grid == 0) {
        if (n_in != 23 || in_sizes[0] != M * D || out_size != M * D || ws_size < WS_END) { fprintf(stderr, "kernel_launch: unexpected shapes (n_in %d, in0 %d, out %d, ws %zu)\n", n_in, n_in > 0 ? in_sizes[0] : -1, out_size, ws_size); grid = -1; return; }
        int dev = 0, cus = 0, per_cu = 0;
        if (hipGetDevice(&dev) != hipSuccess || hipDeviceGetAttribute(&cus, hipDeviceAttributeMultiprocessorCount, dev) != hipSuccess) { grid = -1; return; }
        if (hipFuncSetAttribute((const void*)mk_fwd, hipFuncAttributeMaxDynamicSharedMemorySize, LDS_BYTES) != hipSuccess) { fprintf(stderr, "kernel_launch: hipFuncSetAttribute failed\n"); grid = -1; return; }
        if (hipOccupancyMaxActiveBlocksPerMultiprocessor(&per_cu, (const void*)mk_fwd, NWAVES * 64, LDS_BYTES) != hipSuccess || per_cu < 1) { fprintf(stderr, "kernel_launch: occupancy query says %d blocks per CU\n", per_cu); (void)hipGetLastError(); grid = -1; return; }
        grid = cus;
        if (grid != 256) fprintf(stderr, "kernel_launch: %d CUs (built for 256)\n", grid);
    }
    if (grid < 0) return;
    (void)hipMemsetAsync((char*)d_ws + WS_CTL, 0, CTL_ZERO_BYTES, stream);
    Args a{};
    for (int i = 0; i < 23; ++i) a.in[i] = (const float*)d_in[i];
    a.out = (float*)d_out; a.ws = (unsigned char*)d_ws;
    unsigned char* dout = (unsigned char*)d_out; unsigned char* ws = (unsigned char*)d_ws;
#if MK_N_LAUNCHES == 1
    a.ph_lo = 0; a.ph_hi = 8; a.li = 0;
    hipLaunchKernelGGL(mk_fwd, dim3(grid), dim3(NWAVES * 64), LDS_BYTES, stream, a);
#else
    for (int ph = 0; ph < 8; ++ph) {
        if (ph == 2) {
            hipLaunchKernelGGL(ssd_naive, dim3(BATCH * NH), dim3(64), 0, stream, (const bf16_t*)(ws + WS_XBC), (const float*)(dout + DO_DT), (bf16_t*)(ws + WS_ACAT), (float*)(dout + DO_SSQ),
                               (const float*)d_in[4], (const float*)d_in[5], (const float*)d_in[7], (const float*)d_in[8]);
            hipLaunchKernelGGL(sgu_naive, dim3(M / CHUNK * 16), dim3(64), 0, stream, (const bf16_t*)(dout + DO_V), (const float*)(dout + DO_VST), (bf16_t*)(ws + WS_ACAT),
                               (const float*)d_in[11], (const float*)d_in[12], (const float*)d_in[13], (const float*)d_in[14]);
#if DBG_STOP == 2
            { float* dig = (float*)(ws + WS_SS2); hipLaunchKernelGGL(dbg_digest, dim3(M / 256), dim3(256), 0, stream, (const unsigned char*)dout, dig, 2);
              hipLaunchKernelGGL(dbg_dump, dim3(M * D / 256), dim3(256), 0, stream, (const unsigned char*)ws, (float*)d_out, (const float*)dig, 2); break; }
#endif
            continue;
        }
        a.ph_lo = ph; a.ph_hi = ph + 1; a.li = ph;
        hipLaunchKernelGGL(mk_fwd, dim3(grid), dim3(NWAVES * 64), LDS_BYTES, stream, a);
#if DBG_STOP
        if (ph == DBG_STOP && DBG_STOP != 2) { float* dig = (float*)(ws + WS_SS2);
            if (DBG_STOP == 1) hipLaunchKernelGGL(dbg_digest, dim3(M / 256), dim3(256), 0, stream, (const unsigned char*)dout, dig, 1);
            hipLaunchKernelGGL(dbg_dump, dim3(M * D / 256), dim3(256), 0, stream, (const unsigned char*)ws, (float*)d_out, (const float*)dig, DBG_STOP); break; }
#endif
    }
#endif
}
```

```cpp
#include <hip/hip_runtime.h>
#include <cstdio>
#include <cstdint>

#ifndef NAIVE_P2
#define NAIVE_P2 0
#endif
#ifndef MK_N_LAUNCHES
#define MK_N_LAUNCHES 1
#endif

constexpr int D = 1024, SEQ = 4096, BATCH = 4, M = BATCH * SEQ;
constexpr int DI = 2048, NH = 32, HD = 64, NG = 4, NS = 128, XBCW = 3072, CHUNK = 128;
constexpr int N1 = 7168;
constexpr int FF = 2816;
constexpr int ACAT_LD = 4096;
constexpr int BCAT_LD = 5120;
constexpr float NORM_EPS = 1e-6f, LN_EPS = 1e-5f;

constexpr size_t MiB = 1u << 20;
constexpr size_t WS_CTL = 0, CTL_ZERO_BYTES = 64 * 1024;
constexpr size_t WS_BCAT = 1 * MiB, WS_WOUT = 11 * MiB, WS_WUP = 13 * MiB, WS_WDOWN = 24 * MiB;
constexpr size_t WS_SS2 = 29 * MiB + 512 * 1024, WS_SS3 = 30 * MiB + 512 * 1024;
constexpr size_t WS_ACAT = 32 * MiB, WS_XBC = 160 * MiB, WS_END = 256 * MiB;
constexpr size_t WS_T = 160 * MiB, WS_G = 192 * MiB, WS_H = 192 * MiB, WS_HB = 32 * MiB, WS_ACT = 64 * MiB;
constexpr size_t DO_CB = 32 * MiB;
constexpr size_t WS_WSB = 31 * MiB + 512 * 1024;
constexpr size_t DO_V = 0, DO_W1T = 32 * MiB, DO_DT = 48 * MiB, DO_ACUM = 50 * MiB, DO_SSQ = 52 * MiB, DO_HALO = 56 * MiB, DO_VST = 59 * MiB;

namespace pg8 {
#define PG8_LAS __attribute__((address_space(3)))
typedef unsigned short bf16_t;
typedef short bf16x8 __attribute__((ext_vector_type(8)));
typedef float f32x4 __attribute__((ext_vector_type(4)));
typedef float f32x2 __attribute__((ext_vector_type(2)));
typedef unsigned u32x4 __attribute__((ext_vector_type(4)));
typedef unsigned u32x2 __attribute__((ext_vector_type(2)));
constexpr int BM = 256, BK = 64, HALF = 128, HTB = HALF * BK * 2, STAGE_BYTES = 8 * HTB, NXCD = 8, WGM = 8;

__host__ __device__ __forceinline__ int lds_byte(int r, int c) { const int st = (r >> 4) * 2 + (c >> 5), rr = r & 15, cc = c & 31, ob = rr * 64 + cc * 2; return st * 1024 + (ob ^ (((ob >> 9) & 1) << 5)); }
__host__ __device__ __forceinline__ void stage_rc(int b, int& R, int& C) { const int st = b / 1024, sb = b % 1024, swz = sb ^ (((sb >> 9) & 1) << 5); R = (st >> 1) * 16 + swz / 64; C = (st & 1) * 32 + (swz % 64) / 2; }
__host__ __device__ __forceinline__ int perm32(int rho) { const int n = rho >> 4, i = rho & 15; return 8 * (i >> 2) + 4 * n + (i & 3); }

struct Unit { const char* A; const char* B; int nt, pm, pn, kind; };

__device__ __forceinline__ void tile_of(int L, int nM, int nN, int& pm, int& pn) {
    const int nwg = nM * nN; int wgid = L; { const int q = nwg / NXCD, r = nwg % NXCD, xcd = wgid % NXCD, off = wgid / NXCD; wgid = (xcd < r ? xcd * (q + 1) : r * (q + 1) + (xcd - r) * q) + off; }
    const int nig = WGM * nN, gid = wgid / nig, fm = gid * WGM, gsz = (nM - fm) < WGM ? (nM - fm) : WGM;
    pm = fm + ((wgid % nig) % gsz); pn = (wgid % nig) / gsz;
}

typedef __bf16 bf16x2_t __attribute__((ext_vector_type(2)));
__device__ __forceinline__ unsigned cvt_pk_bf16(float lo, float hi) { const f32x2 v = {lo, hi}; return __builtin_bit_cast(unsigned, __builtin_convertvector(v, bf16x2_t)); }
__device__ __forceinline__ float bf_lo(unsigned w) { return __builtin_bit_cast(float, w << 16); }
__device__ __forceinline__ float bf_hi(unsigned w) { return __builtin_bit_cast(float, w & 0xffff0000u); }
__device__ __forceinline__ float fast_sigmoid(float x) { return __builtin_amdgcn_rcpf(1.0f + __builtin_amdgcn_exp2f(-1.44269504089f * x)); }
__device__ __forceinline__ float fast_silu(float x) { return x * fast_sigmoid(x); }
__device__ __forceinline__ float gelu_tanh(float x) { const float u = 1.5957691216057308f * (x + 0.044715f * x * x * x); return x * fast_sigmoid(u); }

template <class Epi, class Sched, bool ALIGN_EPI, bool MAP62>
__device__ __forceinline__ void gemm_phase(PG8_LAS unsigned char* lds, const int lda, const int ldb, const Sched& S, const Epi& E) {
    const int tid = threadIdx.x, wid = __builtin_amdgcn_readfirstlane(tid >> 6), lane = tid & 63, wr = wid >> 2, wc = wid & 3, fr = lane & 15, fq = lane >> 4;
    unsigned voffA[2], voffB[2];
#pragma unroll
    for (int i = 0; i < 2; ++i) { int R, C; stage_rc(tid * 16 + i * 8192, R, C); const int Rb = Epi::PERM ? ((R & ~31) + perm32(R & 31)) : R; const int Ra = MAP62 ? (R - 2 * (R >> 6)) : R;
        voffA[i] = (unsigned)(Ra * lda + C) * 2u; voffB[i] = (unsigned)(Rb * ldb + C) * 2u; }
    const size_t kstep = (size_t)(BK * 2);
    const size_t hstepA = (size_t)(MAP62 ? 124 : 128) * lda * 2, hstepB = (size_t)HALF * ldb * 2;
    const unsigned ldsw = (unsigned)wid * 1024u;
    const int aoff = lds_byte(wr * 64 + fr, fq * 8), boff = lds_byte(wc * 32 + fr, fq * 8);
#define PG8_SA(b, h) (((b) * 2 + (h)) * HTB)
#define PG8_SB(b, h) ((4 + (b) * 2 + (h)) * HTB)
#define PG8_STAGE(bufoff, gbase, voff) do { _Pragma("unroll") for (int _i = 0; _i < 2; ++_i) \
        __builtin_amdgcn_global_load_lds((const unsigned*)((const char*)(gbase) + (voff)[_i]), (PG8_LAS unsigned*)(lds + (bufoff) + ldsw + _i * 8192), 16, 0, 0); } while (0)
#define PG8_LDA(dst, b, h) do { _Pragma("unroll") for (int m = 0; m < 4; ++m) _Pragma("unroll") for (int k = 0; k < 2; ++k) dst[m][k] = *(const PG8_LAS bf16x8*)(lds + PG8_SA(b, h) + aoff + m * 2048 + k * 1024); } while (0)
#define PG8_LDB(dst, b, h) do { _Pragma("unroll") for (int n = 0; n < 2; ++n) _Pragma("unroll") for (int k = 0; k < 2; ++k) dst[n][k] = *(const PG8_LAS bf16x8*)(lds + PG8_SB(b, h) + boff + n * 2048 + k * 1024); } while (0)
#define PG8_MMA(ai, bj, At, Bt) do { __builtin_amdgcn_s_setprio(1); _Pragma("unroll") for (int m = 0; m < 4; ++m) _Pragma("unroll") for (int n = 0; n < 2; ++n) _Pragma("unroll") for (int k = 0; k < 2; ++k) \
        acc[ai][bj][m][n] = __builtin_amdgcn_mfma_f32_16x16x32_bf16(Bt[n][k], At[m][k], acc[ai][bj][m][n], 0, 0, 0); __builtin_amdgcn_s_setprio(0); } while (0)
#define PG8_WAIT_V(n) asm volatile("s_waitcnt vmcnt(" #n ")" ::: "memory")
#define PG8_WAIT_L(n) asm volatile("s_waitcnt lgkmcnt(" #n ")" ::: "memory")
#define PG8_BAR __builtin_amdgcn_s_barrier()
#define PG8_SCHED __builtin_amdgcn_sched_barrier(0)
    Unit cur, nxt; int ui = 0;
    if (!S.next(0, cur)) return;
    f32x4 acc[2][2][4][2];
#pragma unroll
    for (int a = 0; a < 2; ++a)
#pragma unroll
        for (int b = 0; b < 2; ++b)
#pragma unroll
            for (int m = 0; m < 4; ++m)
#pragma unroll
                for (int n = 0; n < 2; ++n) acc[a][b][m][n] = (f32x4){0.f, 0.f, 0.f, 0.f};
    bf16x8 At[4][2], B0[2][2], B1[2][2];
    const char* cA = cur.A; const char* cB = cur.B;
    PG8_STAGE(PG8_SB(0, 0), cB, voffB); PG8_STAGE(PG8_SB(0, 1), cB + hstepB, voffB); PG8_STAGE(PG8_SA(0, 0), cA, voffA); PG8_STAGE(PG8_SA(0, 1), cA + hstepA, voffA);
    if (wr == 1) PG8_BAR;
    PG8_WAIT_V(2); PG8_BAR;
    PG8_STAGE(PG8_SB(1, 0), cB + kstep, voffB); PG8_STAGE(PG8_SA(1, 0), cA + kstep, voffA); PG8_STAGE(PG8_SB(1, 1), cB + hstepB + kstep, voffB);
    PG8_WAIT_V(6); PG8_BAR;
    for (;;) {
        const bool has_next = S.next(ui + 1, nxt);
        const char* nA = has_next ? nxt.A : cA; const char* nB = has_next ? nxt.B : cB;
        const int nt = cur.nt;
        for (int t = 0; t < nt; t += 2) {
            const bool last = (t == nt - 2);
            const char* a1 = cA + (size_t)(t + 1) * kstep;
            const char* a2 = last ? nA : cA + (size_t)(t + 2) * kstep; const char* b2 = last ? nB : cB + (size_t)(t + 2) * kstep;
            const char* a3 = a2 + kstep; const char* b3 = b2 + kstep;
            PG8_LDB(B0, 0, 0); PG8_LDB(B1, 0, 1); PG8_SCHED; PG8_LDA(At, 0, 0); PG8_STAGE(PG8_SA(1, 1), a1 + hstepA, voffA);
            PG8_WAIT_V(8); PG8_WAIT_L(0); PG8_BAR; PG8_MMA(0, 0, At, B0); PG8_MMA(0, 1, At, B1); PG8_BAR; PG8_SCHED;
            PG8_LDA(At, 0, 1); PG8_STAGE(PG8_SB(0, 0), b2, voffB); PG8_STAGE(PG8_SB(0, 1), b2 + hstepB, voffB); PG8_STAGE(PG8_SA(0, 0), a2, voffA);
            PG8_WAIT_V(8); PG8_WAIT_L(0); PG8_BAR; PG8_MMA(1, 0, At, B0); PG8_MMA(1, 1, At, B1); PG8_BAR; PG8_SCHED;
            PG8_LDB(B0, 1, 0); PG8_LDB(B1, 1, 1); PG8_SCHED; PG8_LDA(At, 1, 0); PG8_STAGE(PG8_SA(0, 1), a2 + hstepA, voffA);
            PG8_WAIT_V(8); PG8_WAIT_L(0); PG8_BAR; PG8_MMA(0, 0, At, B0); PG8_MMA(0, 1, At, B1); PG8_BAR; PG8_SCHED;
            PG8_LDA(At, 1, 1); PG8_STAGE(PG8_SB(1, 0), b3, voffB); PG8_STAGE(PG8_SB(1, 1), b3 + hstepB, voffB); PG8_STAGE(PG8_SA(1, 0), a3, voffA);
            PG8_WAIT_V(8); PG8_WAIT_L(0); PG8_BAR; PG8_MMA(1, 0, At, B0); PG8_MMA(1, 1, At, B1); PG8_BAR; PG8_SCHED;
        }
        if constexpr (ALIGN_EPI) { if (wr == 0) PG8_BAR; }
        E(acc, cur, wr, wc, fr, fq);
        if (!has_next) break;
#pragma unroll
        for (int a = 0; a < 2; ++a)
#pragma unroll
            for (int b = 0; b < 2; ++b)
#pragma unroll
                for (int m = 0; m < 4; ++m)
#pragma unroll
                    for (int n = 0; n < 2; ++n) acc[a][b][m][n] = (f32x4){0.f, 0.f, 0.f, 0.f};
        cur = nxt; cA = nA; cB = nB; ++ui;
        if constexpr (ALIGN_EPI) { if (wr == 1) PG8_BAR; }
    }
    PG8_WAIT_V(0);
    if constexpr (!ALIGN_EPI) { if (wr == 0) PG8_BAR; }
    PG8_BAR;
#undef PG8_SA
#undef PG8_SB
#undef PG8_STAGE
#undef PG8_LDA
#undef PG8_LDB
#undef PG8_MMA
#undef PG8_WAIT_V
#undef PG8_WAIT_L
#undef PG8_BAR
#undef PG8_SCHED
}
}

using pg8::bf16_t; using pg8::f32x4; using pg8::f32x2; using pg8::u32x4; using pg8::u32x2; using pg8::bf16x8; using pg8::Unit;
using pg8::cvt_pk_bf16; using pg8::bf_lo; using pg8::bf_hi; using pg8::fast_sigmoid; using pg8::fast_silu; using pg8::gelu_tanh;

constexpr int NWAVES = 8;
constexpr int RING_BYTES = 131072, LDSCTL_OFF = RING_BYTES, MISC_OFF = LDSCTL_OFF + 320, LDS_BYTES = 147456;
#define GAS __attribute__((address_space(1)))
#define LAS __attribute__((address_space(3)))
typedef GAS unsigned gu32;
#define RLX_AGENT __ATOMIC_RELAXED, __HIP_MEMORY_SCOPE_AGENT
#define LDS_WAIT() asm volatile("s_waitcnt lgkmcnt(0)" ::: "memory")
#define LDS_BAR() do { asm volatile("s_waitcnt lgkmcnt(0)" ::: "memory"); __builtin_amdgcn_s_barrier(); asm volatile("" ::: "memory"); } while (0)
__device__ __forceinline__ unsigned f2bf(float f) { unsigned u = __builtin_bit_cast(unsigned, f); return (u + 0x7fffu + ((u >> 16) & 1u)) >> 16; }
__device__ __forceinline__ unsigned pk2(float lo, float hi) { return f2bf(lo) | (f2bf(hi) << 16); }
__device__ __forceinline__ float bf2f(bf16_t h) { return __builtin_bit_cast(float, (unsigned)h << 16); }
__device__ __forceinline__ float wave_sum(float v) {
#pragma unroll
    for (int o = 1; o < 64; o <<= 1) v += __shfl_xor(v, o);
    return v;
}

#define XB_TMO      128
#define XB_XCNT(j)  (256  + 64 * (j))
#define XB_XSUB(j)  (1280 + 64 * (j))
#define XB_XGEN(j)  (2304 + 64 * (j))
#define XB_TOP      3328
#define XB_TOPGEN   3392
#define XCD_BAR_WORDS 3456
#define XB_SPIN_CAP (1u << 20)
__device__ __forceinline__ unsigned xb_ld(unsigned* p)              { return __hip_atomic_load(p, __ATOMIC_RELAXED, __HIP_MEMORY_SCOPE_AGENT); }
__device__ __forceinline__ unsigned xb_add(unsigned* p, unsigned v) { return __hip_atomic_fetch_add(p, v, __ATOMIC_RELAXED, __HIP_MEMORY_SCOPE_AGENT); }
__device__ __forceinline__ unsigned xb_xcc_id() { return (unsigned)__builtin_amdgcn_s_getreg((3 << 11) | 20) & 0xFu; }
#define XB_SPIN(cond, bar) do { unsigned _sp = 0; while (cond) { __builtin_amdgcn_s_sleep(1); \
    if ((++_sp & 255u) == 0u) { if (xb_ld(&(bar)[XB_TMO])) break; if (_sp > XB_SPIN_CAP) { atomicAdd(&(bar)[XB_TMO], 1u); break; } } } } while (0)
struct XcdBarrier { unsigned* bar; unsigned x; volatile LAS unsigned* st; };
__device__ __forceinline__ XcdBarrier xcd_barrier_post(unsigned* bar, volatile LAS unsigned* st) {
    XcdBarrier b; b.bar = bar; b.x = xb_xcc_id(); b.st = st;
    if (threadIdx.x == 0) (void)xb_add(&bar[XB_XCNT(b.x)], 1u);
    return b;
}
__device__ __forceinline__ void xcd_barrier_complete(unsigned* bar, unsigned x, unsigned& nloc, unsigned& nx) {
    const unsigned G = gridDim.x * gridDim.y * gridDim.z;
    unsigned sum, cnt, mine, sp = 0u;
    for (;;) {
        sum = 0u; cnt = 0u; mine = 0u;
#pragma unroll
        for (unsigned j = 0; j < 16; ++j) { const unsigned c = xb_ld(&bar[XB_XCNT(j)]); sum += c; cnt += (c > 0u) ? 1u : 0u; mine = (j == x) ? c : mine; }
        if (sum == G) break;
        __builtin_amdgcn_s_sleep(1);
        if ((++sp & 255u) == 0u) { if (xb_ld(&bar[XB_TMO])) break; if (sp > XB_SPIN_CAP) { atomicAdd(&bar[XB_TMO], 1u); break; } }
    }
    nloc = mine > 0u ? mine : 1u; nx = cnt > 0u ? cnt : 1u;
}
__device__ __forceinline__ void xcd_barrier(const XcdBarrier& b) {
    asm volatile("s_waitcnt vmcnt(0)" ::: "memory");
    __syncthreads();
    if (threadIdx.x == 0) {
        unsigned* bar = b.bar;
        __builtin_amdgcn_s_waitcnt(0);
        unsigned nloc = b.st[0], nx = b.st[1];
        if (nloc == 0u) { xcd_barrier_complete(bar, b.x, nloc, nx); b.st[0] = nloc; b.st[1] = nx; }
        const unsigned old = xb_add(&bar[XB_XSUB(b.x)], 1u);
        const unsigned gen = old / nloc;
        if (old + 1u == (gen + 1u) * nloc) {
            __builtin_amdgcn_fence(__ATOMIC_RELEASE, "agent");
            asm volatile("s_waitcnt vmcnt(0)" ::: "memory");
            const unsigned og = xb_add(&bar[XB_TOP], 1u);
            const unsigned tg = og / nx;
            if (og + 1u == (tg + 1u) * nx) xb_add(&bar[XB_TOPGEN], 1u);
            else XB_SPIN(xb_ld(&bar[XB_TOPGEN]) == tg, bar);
            __builtin_amdgcn_fence(__ATOMIC_ACQUIRE, "agent");
            xb_add(&bar[XB_XGEN(b.x)], 1u);
            asm volatile("s_waitcnt vmcnt(0)" ::: "memory");
        } else {
            XB_SPIN(xb_ld(&bar[XB_XGEN(b.x)]) == gen, bar);
            __builtin_amdgcn_fence(__ATOMIC_ACQUIRE, "agent");
            asm volatile("s_waitcnt vmcnt(0)" ::: "memory");
        }
    }
    __syncthreads();
}

struct Frame {
    LAS unsigned char* lds; volatile LAS unsigned* MISC; gu32* ctl;
    int tid, lane, wave, vcu, G;
    const float* in[23]; float* out; unsigned char* ws;
};
constexpr int CW_BAR = 4096;

__device__ __forceinline__ void p0_transpose_item(const float* W, int ldw, int k0, int c0, const float* sc, bf16_t* WT, int ldt, int n0, int kd0, LAS float* scr, int lane) {
    f32x4 v[8]; float sv[8];
#pragma unroll
    for (int i = 0; i < 8; ++i) { const int kk = 8 * i + (lane >> 3); v[i] = *(const f32x4*)(W + (size_t)(k0 + kk) * ldw + c0 + 4 * (lane & 7)); sv[i] = sc ? sc[k0 + kk] : 1.0f; }
#pragma unroll
    for (int i = 0; i < 8; ++i) { const int kk = 8 * i + (lane >> 3); LAS float* d = scr + kk * 33 + 4 * (lane & 7); d[0] = v[i][0] * sv[i]; d[1] = v[i][1] * sv[i]; d[2] = v[i][2] * sv[i]; d[3] = v[i][3] * sv[i]; }
    LDS_WAIT(); asm volatile("" ::: "memory");
    const int c = lane & 7;
#pragma unroll
    for (int j = 0; j < 4; ++j) { const int n = (lane >> 3) + 8 * j; const LAS float* s = scr + (8 * c) * 33 + n;
        u32x4 o; o.x = cvt_pk_bf16(s[0 * 33], s[1 * 33]); o.y = cvt_pk_bf16(s[2 * 33], s[3 * 33]); o.z = cvt_pk_bf16(s[4 * 33], s[5 * 33]); o.w = cvt_pk_bf16(s[6 * 33], s[7 * 33]);
        *(u32x4*)(WT + (size_t)(n0 + n) * ldt + kd0 + 8 * c) = o; }
    LDS_WAIT(); asm volatile("" ::: "memory");
}
__device__ __forceinline__ void p0_prologue(Frame& F) {
    LAS float* scr = (LAS float*)(F.lds + F.wave * 16384);
    const int gw = F.vcu * NWAVES + F.wave, NGW = F.G * NWAVES, lane = F.lane;
    const float* norm1_w = F.in[1]; const float* w_in = F.in[2]; const float* ssd_norm_w = F.in[9]; const float* w_branch = F.in[15];
    const float* w_out = F.in[16]; const float* norm2_w = F.in[17]; const float* w_up = F.in[18]; const float* w_down = F.in[21];
    bf16_t* W1t = (bf16_t*)((unsigned char*)F.out + DO_W1T); bf16_t* Bcat = (bf16_t*)(F.ws + WS_BCAT); bf16_t* Woutt = (bf16_t*)(F.ws + WS_WOUT);
    bf16_t* Wupt = (bf16_t*)(F.ws + WS_WUP); bf16_t* Wdownt = (bf16_t*)(F.ws + WS_WDOWN);
    constexpr int I_W1 = 16 * 225, I_GA = 16 * 32, I_PA = 32 * 32, I_PB = 16 * 32, I_GB = 16 * 32, I_WO = 16 * 32, I_UP = 16 * 176, I_DN = 44 * 32;
    constexpr int NITEMS = I_W1 + I_GA + I_PA + I_PB + I_GB + I_WO + I_UP + I_DN;
    for (int it = gw; it < NITEMS; it += NGW) {
        int r = it;
        if (r < I_W1) { const int kb = r / 225, nb = r % 225, n = 32 * nb; const int c = n < 5120 ? n : (n < 7168 ? n + 32 : n - 2048);
            p0_transpose_item(w_in, 9248, 64 * kb, c, norm1_w, W1t, D, n, 64 * kb, scr, lane); continue; } r -= I_W1;
        if (r < I_GA) { const int kb = r / 32, nb = r % 32; p0_transpose_item(w_in, 9248, 64 * kb, 7200 + 32 * nb, norm1_w, Bcat, BCAT_LD, 32 * nb, 64 * kb, scr, lane); continue; } r -= I_GA;
        if (r < I_PA) { const int kb = r / 32, nb = r % 32; p0_transpose_item(w_branch, D, 64 * kb, 32 * nb, ssd_norm_w, Bcat, BCAT_LD, 32 * nb, 1024 + 64 * kb, scr, lane); continue; } r -= I_PA;
        if (r < I_PB) { const int kb = r / 32, nb = r % 32; p0_transpose_item(w_branch + (size_t)DI * D, D, 64 * kb, 32 * nb, nullptr, Bcat, BCAT_LD, 32 * nb, 3072 + 64 * kb, scr, lane); continue; } r -= I_PB;
        if (r < I_GB) { const int kb = r / 32, nb = r % 32; p0_transpose_item(w_in, 9248, 64 * kb, 8224 + 32 * nb, norm1_w, Bcat, BCAT_LD, 32 * nb, 4096 + 64 * kb, scr, lane); continue; } r -= I_GB;
        if (r < I_WO) { const int kb = r / 32, nb = r % 32; p0_transpose_item(w_out, D, 64 * kb, 32 * nb, nullptr, Woutt, D, 32 * nb, 64 * kb, scr, lane); continue; } r -= I_WO;
        if (r < I_UP) { const int kb = r / 176, nb = r % 176, n = 32 * nb, j = n >> 8, w = n & 255; const int c = w < 128 ? 128 * j + w : FF + 128 * j + (w - 128);
            p0_transpose_item(w_up, 2 * FF, 64 * kb, c, norm2_w, Wupt, D, n, 64 * kb, scr, lane); continue; } r -= I_UP;
        { const int kb = r / 32, nb = r % 32; p0_transpose_item(w_down, D, 64 * kb, 32 * nb, nullptr, Wdownt, FF, 32 * nb, 64 * kb, scr, lane); }
    }
    { const float* wsp = F.in[13]; bf16_t* Wsb = (bf16_t*)(F.ws + WS_WSB);
        for (int i = (int)blockIdx.x * 512 + F.tid; i < 8 * CHUNK * CHUNK; i += F.G * 512) { const int t = (i >> 7) & 127, sidx = i & 127; Wsb[i] = (bf16_t)f2bf(sidx <= t ? wsp[i] : 0.f); } }
    const float* x = F.in[0]; bf16_t* ACAT = (bf16_t*)(F.ws + WS_ACAT);
    for (int m0 = gw; m0 < M; m0 += 4 * NGW) {
        f32x4 v[4][4];
#pragma unroll
        for (int r = 0; r < 4; ++r) { const GAS f32x4* xr = (const GAS f32x4*)(x + (size_t)(m0 + r * NGW) * D) + lane;
#pragma unroll
            for (int j = 0; j < 4; ++j) v[r][j] = xr[64 * j]; }
#pragma unroll
        for (int r = 0; r < 4; ++r) { float s = 0.f;
#pragma unroll
            for (int j = 0; j < 4; ++j) s += (v[r][j].x * v[r][j].x + v[r][j].y * v[r][j].y) + (v[r][j].z * v[r][j].z + v[r][j].w * v[r][j].w);
            const float rstd = 1.f / sqrtf(wave_sum(s) * (1.f / D) + NORM_EPS);
            GAS u32x2* o8 = (GAS u32x2*)(ACAT + (size_t)(m0 + r * NGW) * ACAT_LD) + lane;
#pragma unroll
            for (int j = 0; j < 4; ++j) { u32x2 o; o.x = cvt_pk_bf16(v[r][j].x * rstd, v[r][j].y * rstd); o.y = cvt_pk_bf16(v[r][j].z * rstd, v[r][j].w * rstd); o8[64 * j] = o; } }
    }
}

struct SchedP1 {
    const char* A; const char* B; int G, c;
    __device__ __forceinline__ bool next(int i, Unit& u) const {
        const int L = i * G + c; if (L >= 64 * 28) return false;
        pg8::tile_of(L, 64, 28, u.pm, u.pn); u.nt = D / 64; u.kind = 0;
        u.A = A + (size_t)u.pm * 256 * ACAT_LD * 2; u.B = B + (size_t)u.pn * 256 * D * 2; return true;
    }
};
struct EpiP1 {
    static constexpr bool PERM = true;
    bf16_t* ACAT; bf16_t* XBC; bf16_t* V; bf16_t* HALO; float* VST; const float* uv_b;
    __device__ __forceinline__ void operator()(const f32x4 (&acc)[2][2][4][2], const Unit& u, int wr, int wc, int fr, int fq) const {
        const int row0 = u.pm * 256 + wr * 64 + fr, ct = u.pn * 256 + wc * 32 + 8 * fq;
        if (u.pn < 8) {
#pragma unroll
            for (int ai = 0; ai < 2; ++ai)
#pragma unroll
                for (int m = 0; m < 4; ++m) { const int r = row0 + ai * 128 + m * 16;
#pragma unroll
                    for (int bj = 0; bj < 2; ++bj) { const f32x4 v0 = acc[ai][bj][m][0], v1 = acc[ai][bj][m][1]; u32x4 w;
                        w.x = cvt_pk_bf16(fast_silu(v0[0]), fast_silu(v0[1])); w.y = cvt_pk_bf16(fast_silu(v0[2]), fast_silu(v0[3]));
                        w.z = cvt_pk_bf16(fast_silu(v1[0]), fast_silu(v1[1])); w.w = cvt_pk_bf16(fast_silu(v1[2]), fast_silu(v1[3]));
                        *(u32x4*)(ACAT + (size_t)r * ACAT_LD + 1024 + ct + bj * 128) = w; } }
        } else if (u.pn < 20) {
#pragma unroll
            for (int ai = 0; ai < 2; ++ai)
#pragma unroll
                for (int m = 0; m < 4; ++m) { const int r = row0 + ai * 128 + m * 16;
#pragma unroll
                    for (int bj = 0; bj < 2; ++bj) { const f32x4 v0 = acc[ai][bj][m][0], v1 = acc[ai][bj][m][1]; u32x4 w;
                        w.x = cvt_pk_bf16(v0[0], v0[1]); w.y = cvt_pk_bf16(v0[2], v0[3]); w.z = cvt_pk_bf16(v1[0], v1[1]); w.w = cvt_pk_bf16(v1[2], v1[3]);
                        const int c = ct + bj * 128 - 2048;
                        *(u32x4*)(XBC + (size_t)r * XBCW + c) = w;
                        if ((r & 127) >= 125) *(u32x4*)(HALO + (size_t)((r >> 7) * 3 + (r & 127) - 125) * XBCW + c) = w; } }
        } else {
            const bool isv = u.pn >= 24;
#pragma unroll
            for (int ai = 0; ai < 2; ++ai)
#pragma unroll
                for (int m = 0; m < 4; ++m) { const int r = row0 + ai * 128 + m * 16; float s = 0.f, q = 0.f;
#pragma unroll
                    for (int bj = 0; bj < 2; ++bj) { const int c = ct + bj * 128 - 5120;
                        const f32x4 b0 = *(const f32x4*)(uv_b + c), b1 = *(const f32x4*)(uv_b + c + 4);
                        f32x4 v0 = acc[ai][bj][m][0] + b0, v1 = acc[ai][bj][m][1] + b1;
#pragma unroll
                        for (int i = 0; i < 4; ++i) { v0[i] = gelu_tanh(v0[i]); v1[i] = gelu_tanh(v1[i]); s += v0[i] + v1[i]; q += v0[i] * v0[i] + v1[i] * v1[i]; }
                        u32x4 w; w.x = cvt_pk_bf16(v0[0], v0[1]); w.y = cvt_pk_bf16(v0[2], v0[3]); w.z = cvt_pk_bf16(v1[0], v1[1]); w.w = cvt_pk_bf16(v1[2], v1[3]);
                        if (!isv) *(u32x4*)(ACAT + (size_t)r * ACAT_LD + 3072 + c) = w; else *(u32x4*)(V + (size_t)r * D + (c - 1024)) = w; }
                    if (isv) { s += __shfl_xor(s, 16); s += __shfl_xor(s, 32); q += __shfl_xor(q, 16); q += __shfl_xor(q, 32);
                        if (fq == 0) *(f32x2*)(VST + ((size_t)r * 16 + (u.pn - 24) * 4 + wc) * 2) = (f32x2){s, q}; } }
        }
    }
};
__device__ __forceinline__ void p1_dt(Frame& F) {
    const bf16_t* XN = (const bf16_t*)(F.ws + WS_ACAT); const bf16_t* Wdt = (const bf16_t*)((unsigned char*)F.out + DO_W1T) + (size_t)N1 * D;
    float* DT = (float*)((unsigned char*)F.out + DO_DT); const float* dt_bias = F.in[6];
    const int gw = F.vcu * NWAVES + F.wave, NGW = F.G * NWAVES, fr = F.lane & 15, fq = F.lane >> 4;
    for (int item = gw; item < 2048; item += NGW) { const int rb = item >> 1, nb = item & 1;
        f32x4 acc = (f32x4){0.f, 0.f, 0.f, 0.f};
        const bf16_t* ap = XN + (size_t)(rb * 16 + fr) * ACAT_LD + fq * 8; const bf16_t* bp = Wdt + (size_t)(nb * 16 + fr) * D + fq * 8;
#pragma unroll 4
        for (int ks = 0; ks < 32; ++ks) { const bf16x8 a = *(const bf16x8*)(ap + ks * 32), b = *(const bf16x8*)(bp + ks * 32); acc = __builtin_amdgcn_mfma_f32_16x16x32_bf16(a, b, acc, 0, 0, 0); }
        const float bias = dt_bias[nb * 16 + fr];
#pragma unroll
        for (int j = 0; j < 4; ++j) { const float v = acc[j] + bias; const float sp = fmaxf(v, 0.f) + log1pf(expf(-fabsf(v))); DT[(size_t)(rb * 16 + 4 * fq + j) * NH + nb * 16 + fr] = sp; }
    }
}

__device__ __forceinline__ void p2_ssd_naive(Frame& F, int b, int h) {
    const bf16_t* XBC = (const bf16_t*)(F.ws + WS_XBC); const float* DT = (const float*)((unsigned char*)F.out + DO_DT); bf16_t* ACAT = (bf16_t*)(F.ws + WS_ACAT); float* SSQ = (float*)((unsigned char*)F.out + DO_SSQ);
    const float* conv_w = F.in[4]; const float* conv_b = F.in[5]; const float* a_log = F.in[7]; const float* d_skip = F.in[8];
    LAS float* sB = (LAS float*)F.lds; LAS float* sC = sB + 2 * NS;
    const int g = h >> 3, p = F.lane;
    const float a = -expf(a_log[h]), dsk = d_skip[h];
    const int chx = h * HD + p;
    int ch[4]; ch[0] = DI + g * NS + p; ch[1] = ch[0] + 64; ch[2] = DI + NG * NS + g * NS + p; ch[3] = ch[2] + 64;
    float wx[4], wq[4][4]; const float bx = conv_b[chx]; float bq[4];
#pragma unroll
    for (int k = 0; k < 4; ++k) wx[k] = conv_w[k * XBCW + chx];
#pragma unroll
    for (int j = 0; j < 4; ++j) { bq[j] = conv_b[ch[j]];
#pragma unroll
        for (int k = 0; k < 4; ++k) wq[j][k] = conv_w[k * XBCW + ch[j]]; }
    float hs[NS];
#pragma unroll
    for (int n = 0; n < NS; ++n) hs[n] = 0.f;
    float xh[3] = {0.f, 0.f, 0.f}, qh[4][3];
#pragma unroll
    for (int j = 0; j < 4; ++j) { qh[j][0] = 0.f; qh[j][1] = 0.f; qh[j][2] = 0.f; }
    size_t row = (size_t)b * SEQ;
    bf16_t nx = XBC[row * XBCW + chx], nq[4];
#pragma unroll
    for (int j = 0; j < 4; ++j) nq[j] = XBC[row * XBCW + ch[j]];
    float ndt = DT[row * NH + h]; bf16_t nz = ACAT[row * ACAT_LD + 1024 + chx];
    for (int t = 0; t < SEQ; ++t) {
        row = (size_t)b * SEQ + t;
        const float xc = bf2f(nx); float qc[4];
#pragma unroll
        for (int j = 0; j < 4; ++j) qc[j] = bf2f(nq[j]);
        const float dt = ndt; const float zs = bf2f(nz);
        if (t + 1 < SEQ) { const size_t r1 = row + 1; nx = XBC[r1 * XBCW + chx];
#pragma unroll
            for (int j = 0; j < 4; ++j) nq[j] = XBC[r1 * XBCW + ch[j]];
            ndt = DT[r1 * NH + h]; nz = ACAT[r1 * ACAT_LD + 1024 + chx]; }
        const float xv = fast_silu(bx + wx[0] * xh[0] + wx[1] * xh[1] + wx[2] * xh[2] + wx[3] * xc);
        xh[0] = xh[1]; xh[1] = xh[2]; xh[2] = xc;
        const int buf = (t & 1) * NS;
#pragma unroll
        for (int j = 0; j < 4; ++j) { const float v = fast_silu(bq[j] + wq[j][0] * qh[j][0] + wq[j][1] * qh[j][1] + wq[j][2] * qh[j][2] + wq[j][3] * qc[j]);
            qh[j][0] = qh[j][1]; qh[j][1] = qh[j][2]; qh[j][2] = qc[j];
            if (j < 2) sB[buf + p + 64 * j] = v; else sC[buf + p + 64 * (j - 2)] = v; }
        LDS_WAIT(); asm volatile("" ::: "memory");
        const float dA = expf(dt * a), xdt = xv * dt; float y = 0.f;
#pragma unroll
        for (int n = 0; n < NS; n += 4) { const f32x4 Bv = *(const LAS f32x4*)&sB[buf + n], Cv = *(const LAS f32x4*)&sC[buf + n];
#pragma unroll
            for (int i = 0; i < 4; ++i) { hs[n + i] = hs[n + i] * dA + xdt * Bv[i]; y += Cv[i] * hs[n + i]; } }
        y += dsk * xv;
        const float yz = y * zs;
        ACAT[row * ACAT_LD + 1024 + chx] = (bf16_t)f2bf(yz);
        const float ssq = wave_sum(yz * yz);
        if (p == 0) { SSQ[row * 64 + 2 * h] = ssq; SSQ[row * 64 + 2 * h + 1] = 0.f; }
    }
}
__device__ __forceinline__ void p2_sgu_naive(Frame& F, int item, LAS float* sv, LAS float* sst) {
    const bf16_t* V = (const bf16_t*)((unsigned char*)F.out + DO_V); const float* VST = (const float*)((unsigned char*)F.out + DO_VST); bf16_t* ACAT = (bf16_t*)(F.ws + WS_ACAT);
    const float* ln_w = F.in[11]; const float* ln_b = F.in[12]; const float* w_sp = F.in[13]; const float* b_sp = F.in[14];
    const int bc = item >> 5, g = (item >> 2) & 7, qd = item & 3, dl = F.lane & 31, th = F.lane >> 5, d = qd * 32 + dl; const size_t row0 = (size_t)bc * CHUNK;
    for (int s = F.lane; s < CHUNK; s += 64) { float su = 0.f, sq = 0.f;
        for (int j = 0; j < 16; ++j) { su += VST[((row0 + s) * 16 + j) * 2]; sq += VST[((row0 + s) * 16 + j) * 2 + 1]; }
        const float mu = su * (1.0f / D); const float var = fmaxf(sq * (1.0f / D) - mu * mu, 0.f); sst[2 * s] = mu; sst[2 * s + 1] = 1.0f / sqrtf(var + LN_EPS); }
    LDS_WAIT(); asm volatile("" ::: "memory");
    const float lw = ln_w[g * NS + d], lb = ln_b[g * NS + d];
    for (int s = th; s < CHUNK; s += 2) sv[s * 32 + dl] = (bf2f(V[(row0 + s) * D + g * NS + d]) - sst[2 * s]) * sst[2 * s + 1] * lw + lb;
    LDS_WAIT(); asm volatile("" ::: "memory");
    for (int t = th; t < CHUNK; t += 2) { const float* wr = w_sp + ((size_t)g * CHUNK + t) * CHUNK; float mix = b_sp[g * CHUNK + t];
        for (int s = 0; s <= t; ++s) mix += wr[s] * sv[s * 32 + dl];
        bf16_t* up = ACAT + (row0 + t) * ACAT_LD + 3072 + g * NS + d;
        *up = (bf16_t)f2bf(bf2f(*up) * mix); }
    LDS_WAIT(); asm volatile("" ::: "memory");
}
__device__ __forceinline__ void p2_naive(Frame& F) {
    if (blockIdx.x < BATCH * NH) { if (F.wave == 0) p2_ssd_naive(F, (int)blockIdx.x >> 5, (int)blockIdx.x & 31); }
    else { const int wv = ((int)blockIdx.x - BATCH * NH) * NWAVES + F.wave, nwv = (F.G - BATCH * NH) * NWAVES;
        LAS float* sv = (LAS float*)(F.lds + F.wave * 16384); LAS float* sst = (LAS float*)(F.lds + MISC_OFF + 128 + F.wave * 1024);
        for (int item = wv; item < (M / CHUNK) * 32; item += nwv) p2_sgu_naive(F, item, sv, sst); }
}

__device__ __forceinline__ int swz128(int row, int chunk) { return row * 256 + ((chunk ^ (row & 15)) << 4); }
__device__ __forceinline__ float fast_exp(float x) { return __builtin_amdgcn_exp2f(1.44269504089f * x); }
__device__ __forceinline__ void unpack8(const u32x4 w, float (&f)[8]) { f[0] = bf_lo(w.x); f[1] = bf_hi(w.x); f[2] = bf_lo(w.y); f[3] = bf_hi(w.y); f[4] = bf_lo(w.z); f[5] = bf_hi(w.z); f[6] = bf_lo(w.w); f[7] = bf_hi(w.w); }
__device__ __forceinline__ u32x4 pack8(const float (&f)[8]) { u32x4 w; w.x = cvt_pk_bf16(f[0], f[1]); w.y = cvt_pk_bf16(f[2], f[3]); w.z = cvt_pk_bf16(f[4], f[5]); w.w = cvt_pk_bf16(f[6], f[7]); return w; }
#define MFMA16(a, b, c) __builtin_amdgcn_mfma_f32_16x16x32_bf16(__builtin_bit_cast(bf16x8, a), __builtin_bit_cast(bf16x8, b), c, 0, 0, 0)

__device__ __forceinline__ void p2a_bc_item(Frame& F, int item) {
    const int bc = item >> 2, g = item & 3, c = bc & 31, tid = F.tid, lane = F.lane, w = F.wave, fr = lane & 15, fq = lane >> 4; const size_t row0 = (size_t)bc * CHUNK;
    bf16_t* XBC = (bf16_t*)(F.ws + WS_XBC); const bf16_t* HALO = (const bf16_t*)((unsigned char*)F.out + DO_HALO); const float* conv_w = F.in[4]; const float* conv_b = F.in[5];
    LAS unsigned char* Bl = F.lds; LAS unsigned char* Cl = F.lds + 32768;
#pragma unroll 2
    for (int k = 0; k < 8; ++k) { const int idx = tid + 512 * k, mat = idx >> 11, rem = idx & 2047, s = rem >> 4, ch = rem & 15; const int col = DI + mat * 512 + g * NS + ch * 8;
        float a[8];
        { const f32x4 b0 = *(const f32x4*)(conv_b + col), b1 = *(const f32x4*)(conv_b + col + 4); a[0] = b0[0]; a[1] = b0[1]; a[2] = b0[2]; a[3] = b0[3]; a[4] = b1[0]; a[5] = b1[1]; a[6] = b1[2]; a[7] = b1[3]; }
#pragma unroll
        for (int j = 0; j < 4; ++j) { const int rr = s - 3 + j; u32x4 rw = (u32x4){0u, 0u, 0u, 0u};
            if (rr >= 0) rw = *(const u32x4*)(XBC + (row0 + rr) * XBCW + col); else if (c > 0) rw = *(const u32x4*)(HALO + (size_t)((bc - 1) * 3 + rr + 3) * XBCW + col);
            float x[8]; unpack8(rw, x); const f32x4 w0 = *(const f32x4*)(conv_w + j * XBCW + col), w1 = *(const f32x4*)(conv_w + j * XBCW + col + 4);
#pragma unroll
            for (int i = 0; i < 4; ++i) { a[i] += w0[i] * x[i]; a[4 + i] += w1[i] * x[4 + i]; } }
#pragma unroll
        for (int i = 0; i < 8; ++i) a[i] = fast_silu(a[i]);
        *(LAS u32x4*)((mat ? Cl : Bl) + swz128(s, ch)) = pack8(a); }
    __syncthreads();
#pragma unroll
    for (int k = 0; k < 4; ++k) { const int idx = tid + 512 * k, s = idx >> 4, ch = idx & 15;
        *(u32x4*)(XBC + (row0 + 16 * (s >> 4) + ch) * XBCW + DI + 512 + g * NS + 8 * (s & 15)) = *(const LAS u32x4*)(Cl + swz128(s, ch));
        const int n = s, sc = ch; unsigned short e[8];
#pragma unroll
        for (int j = 0; j < 8; ++j) e[j] = *(const LAS unsigned short*)(Bl + swz128(8 * sc + j, n >> 3) + (n & 7) * 2);
        u32x4 o; o.x = e[0] | ((unsigned)e[1] << 16); o.y = e[2] | ((unsigned)e[3] << 16); o.z = e[4] | ((unsigned)e[5] << 16); o.w = e[6] | ((unsigned)e[7] << 16);
        *(u32x4*)(XBC + (row0 + 16 * (n >> 4) + sc) * XBCW + DI + g * NS + 8 * (n & 15)) = o; }
    { bf16_t* CB = (bf16_t*)((unsigned char*)F.out + DO_CB) + (size_t)item * CHUNK * CHUNK;
        u32x4 cf[4];
#pragma unroll
        for (int ks = 0; ks < 4; ++ks) cf[ks] = *(const LAS u32x4*)(Cl + swz128(16 * w + fr, 4 * ks + fq));
        for (int sb = 0; sb <= (w | 1); ++sb) { f32x4 acc = (f32x4){0.f, 0.f, 0.f, 0.f};
#pragma unroll
            for (int ks = 0; ks < 4; ++ks) { const u32x4 af = *(const LAS u32x4*)(Bl + swz128(16 * sb + fr, 4 * ks + fq)); acc = MFMA16(af, cf[ks], acc); }
            u32x2 o; o.x = cvt_pk_bf16(acc[0], acc[1]); o.y = cvt_pk_bf16(acc[2], acc[3]);
            { const int s0 = 16 * sb + 4 * fq; *(u32x2*)(CB + (size_t)(((w * 4 + (s0 >> 5)) * 64 + ((s0 >> 3) & 3) * 16 + fr) * 8 + (s0 & 7))) = o; } } }
    { const int h = 8 * g + w; const float* DT = (const float*)((unsigned char*)F.out + DO_DT); float* AC = (float*)((unsigned char*)F.out + DO_ACUM); const float ah = -expf(F.in[7][h]);
        const float v0 = DT[(row0 + 2 * lane) * NH + h] * ah, v1 = v0 + DT[(row0 + 2 * lane + 1) * NH + h] * ah; float sc = v1;
#pragma unroll
        for (int o = 1; o < 64; o <<= 1) { const float t = __shfl_up(sc, o); if (lane >= o) sc += t; }
        const float ex = sc - v1; AC[(row0 + 2 * lane) * NH + h] = ex + v0; AC[(row0 + 2 * lane + 1) * NH + h] = ex + v1; }
    __syncthreads();
}
__device__ __forceinline__ void p2a_sgu_item(Frame& F, int item) {
    const int bc = item >> 3, g = item & 7, tid = F.tid, lane = F.lane, w = F.wave, fr = lane & 15, fq = lane >> 4; const size_t row0 = (size_t)bc * CHUNK;
    const bf16_t* V = (const bf16_t*)((unsigned char*)F.out + DO_V); const float* VST = (const float*)((unsigned char*)F.out + DO_VST); bf16_t* ACAT = (bf16_t*)(F.ws + WS_ACAT);
    const bf16_t* Wsb = (const bf16_t*)(F.ws + WS_WSB) + (size_t)g * CHUNK * CHUNK; const float* ln_w = F.in[11] + g * NS; const float* ln_b = F.in[12] + g * NS; const float* b_sp = F.in[14] + g * CHUNK;
    LAS unsigned char* LT = F.lds; LAS float* st = (LAS float*)(F.lds + 32768);
    if (tid < CHUNK) { const float* p = VST + (row0 + tid) * 32; float su = 0.f, sq = 0.f;
#pragma unroll
        for (int j = 0; j < 8; ++j) { const f32x4 q = *(const f32x4*)(p + 4 * j); su += q[0] + q[2]; sq += q[1] + q[3]; }
        const float mu = su * (1.0f / D), var = fmaxf(sq * (1.0f / D) - mu * mu, 0.f); st[2 * tid] = mu; st[2 * tid + 1] = 1.0f / sqrtf(var + LN_EPS); }
    __syncthreads();
#pragma unroll
    for (int k = 0; k < 4; ++k) { const int idx = tid + 512 * k, s = idx >> 4, ch = idx & 15;
        float x[8]; unpack8(*(const u32x4*)(V + (row0 + s) * D + g * NS + ch * 8), x); const float mu = st[2 * s], rs = st[2 * s + 1];
        const f32x4 w0 = *(const f32x4*)(ln_w + ch * 8), w1 = *(const f32x4*)(ln_w + ch * 8 + 4), b0 = *(const f32x4*)(ln_b + ch * 8), b1 = *(const f32x4*)(ln_b + ch * 8 + 4);
#pragma unroll
        for (int i = 0; i < 8; ++i) { const float y = (x[i] - mu) * rs * (i < 4 ? w0[i] : w1[i - 4]) + (i < 4 ? b0[i] : b1[i - 4]); const int d = ch * 8 + i;
            *(LAS unsigned short*)(LT + swz128(d, s >> 3) + (s & 7) * 2) = (unsigned short)f2bf(y); } }
    __syncthreads();
    f32x4 acc[8];
#pragma unroll
    for (int db = 0; db < 8; ++db) acc[db] = (f32x4){0.f, 0.f, 0.f, 0.f};
    const int kmax = (16 * w + 15) >> 5;
    for (int ks = 0; ks <= kmax; ++ks) { const u32x4 wf = *(const u32x4*)(Wsb + (size_t)(16 * w + fr) * CHUNK + 32 * ks + 8 * fq);
#pragma unroll
        for (int db = 0; db < 8; ++db) { const u32x4 af = *(const LAS u32x4*)(LT + swz128(16 * db + fr, 4 * ks + fq)); acc[db] = MFMA16(af, wf, acc[db]); } }
    const int t = 16 * w + fr; const float bs = b_sp[t];
#pragma unroll
    for (int db = 0; db < 8; ++db) { bf16_t* up = ACAT + (row0 + t) * ACAT_LD + 3072 + g * NS + 16 * db + 4 * fq; const u32x2 u = *(const u32x2*)up; u32x2 o;
        o.x = cvt_pk_bf16(bf_lo(u.x) * (acc[db][0] + bs), bf_hi(u.x) * (acc[db][1] + bs)); o.y = cvt_pk_bf16(bf_lo(u.y) * (acc[db][2] + bs), bf_hi(u.y) * (acc[db][3] + bs)); *(u32x2*)up = o; }
    __syncthreads();
}
__device__ __forceinline__ void p2a_phase(Frame& F) {
    for (int it = (int)blockIdx.x; it < 512; it += F.G) p2a_bc_item(F, it);
    for (int it = (int)blockIdx.x; it < 1024; it += F.G) p2a_sgu_item(F, it);
}
constexpr int P2B_XD = 0, P2B_XF = 10240, P2B_XS = 20480, P2B_ST = 30720, P2B_AC = 40960, P2B_BUF = 41472, P2B_PITCH = 80;
typedef short s16x4 __attribute__((ext_vector_type(4)));
__device__ __forceinline__ bf16x8 tr_frag(LAS unsigned char* p) {
    const s16x4 a = __builtin_amdgcn_ds_read_tr16_b64_v4i16((LAS s16x4*)p), b = __builtin_amdgcn_ds_read_tr16_b64_v4i16((LAS s16x4*)(p + 4 * P2B_PITCH));
    return __builtin_shufflevector(a, b, 0, 1, 2, 3, 4, 5, 6, 7);
}
struct P2bStageRegs { u32x4 raw[4]; float dt, ac, aend, atot; };
struct P2bCompRegs { u32x4 cb[3], cbd, cc[4], bt[4]; u32x2 zz[2]; float dt; };
__device__ __forceinline__ void p2b_chain(Frame& F) {
    const int id = F.vcu; if (id >= 256) return;
    const int b = id >> 6, g = (id >> 4) & 3, h = 8 * g + ((id >> 1) & 7), ph = id & 1, tid = F.tid, lane = F.lane, w = F.wave, fr = lane & 15, fq = lane >> 4;
    unsigned char* dout = (unsigned char*)F.out;
    const float dsk = F.in[8][h];
    const int sl = tid >> 2, pc = tid & 3, xcol = h * HD + ph * 32 + 8 * pc, lcol = 16 * w + fr, kd = w >> 1;
    const size_t rowb = (size_t)b * SEQ;
    const bf16_t* q_cb = (const bf16_t*)(dout + DO_CB) + (size_t)(b * 32 * 4 + g) * CHUNK * CHUNK + (size_t)(w * 256 + lane) * 8;
    const bf16_t* q_c = (const bf16_t*)(F.ws + WS_XBC) + (rowb + 16 * w + fq) * XBCW + DI + 512 + g * NS + 8 * fr;
    const bf16_t* q_z = (const bf16_t*)(F.ws + WS_ACAT) + (rowb + lcol) * ACAT_LD + 1024 + h * HD + ph * 32 + 4 * fq;
    bf16_t* q_y = (bf16_t*)(F.ws + WS_ACAT) + (rowb + lcol) * ACAT_LD + 1024 + h * HD + ph * 32 + 4 * fq;
    const float* q_dtl = (const float*)(dout + DO_DT) + (rowb + lcol) * NH + h;
    float* q_ssq = (float*)(dout + DO_SSQ) + (rowb + lcol) * 64 + 2 * h + ph;
    const bf16_t* s_x = (const bf16_t*)(F.ws + WS_XBC) + (size_t)((long)(rowb + sl) - 3) * XBCW + xcol;
    const float* s_dt = (const float*)(dout + DO_DT) + (rowb + sl) * NH + h; const float* s_ac = (const float*)(dout + DO_ACUM) + (rowb + sl) * NH + h;
    const float* s_ae = (const float*)(dout + DO_ACUM) + (rowb + (sl | 31)) * NH + h; const float* s_at = (const float*)(dout + DO_ACUM) + (rowb + CHUNK - 1) * NH + h;
    LAS float* CW = (LAS float*)(F.lds + 2 * P2B_BUF);
    if (tid < 160) { const int j = tid >> 5, ch = tid & 31; CW[tid] = j < 4 ? F.in[4][j * XBCW + h * HD + ph * 32 + ch] : F.in[5][h * HD + ph * 32 + ch]; }
    f32x4 st[2] = {(f32x4){0.f, 0.f, 0.f, 0.f}, (f32x4){0.f, 0.f, 0.f, 0.f}};
    for (int i = tid; i < 10240 / 4; i += 512) ((LAS unsigned*)(F.lds + P2B_ST))[i] = 0u;
    __syncthreads();
    const int troff = (8 * fq + (fr >> 2)) * P2B_PITCH + 8 * (fr & 3);
    const int ediag = fr - 8 * fq + 16 * (w & 1);
#define P2B_LOAD_STAGE(R, first) do { \
        _Pragma("unroll") for (int j = 0; j < 4; ++j) { R.raw[j] = (u32x4){0u, 0u, 0u, 0u}; if (!(first) || sl + j >= 3) R.raw[j] = *(const u32x4*)(s_x + (size_t)j * XBCW); } \
        R.dt = *s_dt; R.ac = *s_ac; R.aend = *s_ae; R.atot = *s_at; \
        s_x += (size_t)CHUNK * XBCW; s_dt += CHUNK * NH; s_ac += CHUNK * NH; s_ae += CHUNK * NH; s_at += CHUNK * NH; } while (0)
#define P2B_LOAD_COMP(R) do { \
        _Pragma("unroll") for (int ks = 0; ks < 3; ++ks) if (ks < kd) R.cb[ks] = *(const u32x4*)(q_cb + 512 * ks); \
        R.cbd = *(const u32x4*)(q_cb + 512 * kd); \
        _Pragma("unroll") for (int ks = 0; ks < 4; ++ks) { R.cc[ks] = *(const u32x4*)(q_c + (size_t)(4 * ks) * XBCW); R.bt[ks] = *(const u32x4*)(q_c - 512 + (size_t)(4 * ks) * XBCW); } \
        R.zz[0] = *(const u32x2*)q_z; R.zz[1] = *(const u32x2*)(q_z + 16); R.dt = *q_dtl; \
        q_cb += 4 * CHUNK * CHUNK; q_c += (size_t)CHUNK * XBCW; q_z += (size_t)CHUNK * ACAT_LD; q_dtl += CHUNK * NH; } while (0)
#define P2B_STAGE(R, Lb) do { float a[8]; \
        { const f32x4 b0 = *(const LAS f32x4*)(CW + 128 + 8 * pc), b1 = *(const LAS f32x4*)(CW + 132 + 8 * pc); a[0] = b0[0]; a[1] = b0[1]; a[2] = b0[2]; a[3] = b0[3]; a[4] = b1[0]; a[5] = b1[1]; a[6] = b1[2]; a[7] = b1[3]; } \
        _Pragma("unroll") for (int j = 0; j < 4; ++j) { float x[8]; unpack8(R.raw[j], x); const f32x4 w0 = *(const LAS f32x4*)(CW + 32 * j + 8 * pc), w1 = *(const LAS f32x4*)(CW + 32 * j + 8 * pc + 4); \
            _Pragma("unroll") for (int i = 0; i < 4; ++i) { a[i] += w0[i] * x[i]; a[4 + i] += w1[i] * x[4 + i]; } } \
        const float fe = fast_exp(R.aend - R.ac), de = fast_exp(R.atot - R.ac); float xd[8], xf[8], xs[8]; \
        _Pragma("unroll") for (int i = 0; i < 8; ++i) { xd[i] = fast_silu(a[i]) * R.dt; xf[i] = xd[i] * fe; xs[i] = xd[i] * de; } \
        *(LAS u32x4*)((Lb) + P2B_XD + sl * P2B_PITCH + 16 * pc) = pack8(xd); *(LAS u32x4*)((Lb) + P2B_XF + sl * P2B_PITCH + 16 * pc) = pack8(xf); *(LAS u32x4*)((Lb) + P2B_XS + sl * P2B_PITCH + 16 * pc) = pack8(xs); \
        if (pc == 0) *(LAS float*)((Lb) + P2B_AC + sl * 4) = R.ac; } while (0)
#define P2B_COMPUTE(CR, L, Ln) do { \
        const float acme = *(const LAS float*)((L) + P2B_AC + lcol * 4), atot = *(const LAS float*)((L) + P2B_AC + 127 * 4); \
        const float el = fast_exp(acme), eA = fast_exp(atot), dd = dsk * __builtin_amdgcn_rcpf(CR.dt); \
        f32x4 ad[2] = {(f32x4){0.f, 0.f, 0.f, 0.f}, (f32x4){0.f, 0.f, 0.f, 0.f}}, ao[2] = {(f32x4){0.f, 0.f, 0.f, 0.f}, (f32x4){0.f, 0.f, 0.f, 0.f}}; \
        st[0] = st[0] * eA; st[1] = st[1] * eA; \
          \
        _Pragma("unroll") for (int ks = 0; ks < 3; ++ks) if (ks < kd) { \
            if (ks > 0) { const float rr_ = fast_exp(*(const LAS float*)((L) + P2B_AC + (32 * ks + 31) * 4) - *(const LAS float*)((L) + P2B_AC + (32 * ks - 1) * 4)); ad[0] = ad[0] * rr_; ad[1] = ad[1] * rr_; } \
            _Pragma("unroll") for (int pb = 0; pb < 2; ++pb) ad[pb] = __builtin_amdgcn_mfma_f32_16x16x32_bf16(tr_frag((L) + P2B_XF + troff + ks * 32 * P2B_PITCH + pb * 32), __builtin_bit_cast(bf16x8, CR.cb[ks]), ad[pb], 0, 0, 0); } \
        if (kd > 0) { const float gl = fast_exp(acme - *(const LAS float*)((L) + P2B_AC + (32 * kd - 1) * 4)); ad[0] = ad[0] * gl; ad[1] = ad[1] * gl; } \
          \
        { float m[8]; unpack8(CR.cbd, m); const f32x4 a0 = *(const LAS f32x4*)((L) + P2B_AC + (32 * kd + 8 * fq) * 4), a1 = *(const LAS f32x4*)((L) + P2B_AC + (32 * kd + 8 * fq) * 4 + 16); \
            int ed = ediag; asm volatile("" : "+v"(ed)); \
            _Pragma("unroll") for (int j = 0; j < 8; ++j) { const float as = j < 4 ? a0[j] : a1[j - 4]; const float dcy = fast_exp(fminf(acme - as, 0.f)); const float lt = j < ed ? 1.f : 0.f, eq = j == ed ? 1.f : 0.f; m[j] = m[j] * (dcy * lt + eq) + dd * eq; } \
            const u32x4 mf = pack8(m); \
            _Pragma("unroll") for (int pb = 0; pb < 2; ++pb) ad[pb] = __builtin_amdgcn_mfma_f32_16x16x32_bf16(tr_frag((L) + P2B_XD + troff + kd * 32 * P2B_PITCH + pb * 32), __builtin_bit_cast(bf16x8, mf), ad[pb], 0, 0, 0); } \
        _Pragma("unroll") for (int ks = 0; ks < 4; ++ks) { \
            _Pragma("unroll") for (int pb = 0; pb < 2; ++pb) { ao[pb] = __builtin_amdgcn_mfma_f32_16x16x32_bf16(tr_frag((L) + P2B_ST + troff + ks * 32 * P2B_PITCH + pb * 32), __builtin_bit_cast(bf16x8, CR.cc[ks]), ao[pb], 0, 0, 0); \
                st[pb] = __builtin_amdgcn_mfma_f32_16x16x32_bf16(tr_frag((L) + P2B_XS + troff + ks * 32 * P2B_PITCH + pb * 32), __builtin_bit_cast(bf16x8, CR.bt[ks]), st[pb], 0, 0, 0); } } \
        float ssq = 0.f; \
        _Pragma("unroll") for (int pb = 0; pb < 2; ++pb) { const u32x2 zz = CR.zz[pb]; const f32x4 y = ad[pb] + ao[pb] * el; \
            const float y0 = y[0] * bf_lo(zz.x), y1 = y[1] * bf_hi(zz.x), y2 = y[2] * bf_lo(zz.y), y3 = y[3] * bf_hi(zz.y); \
            ssq += (y0 * y0 + y1 * y1) + (y2 * y2 + y3 * y3); u32x2 o; o.x = cvt_pk_bf16(y0, y1); o.y = cvt_pk_bf16(y2, y3); *(u32x2*)(q_y + 16 * pb) = o; } \
        ssq += __shfl_xor(ssq, 16); ssq += __shfl_xor(ssq, 32); \
        if (fq == 0) *q_ssq = ssq; \
        q_y += (size_t)CHUNK * ACAT_LD; q_ssq += CHUNK * 64; \
        _Pragma("unroll") for (int pb = 0; pb < 2; ++pb) { u32x2 o; o.x = cvt_pk_bf16(st[pb][0], st[pb][1]); o.y = cvt_pk_bf16(st[pb][2], st[pb][3]); *(LAS u32x2*)((Ln) + P2B_ST + lcol * P2B_PITCH + (16 * pb + 4 * fq) * 2) = o; } \
    } while (0)
#define P2B_TOUCH_C(R) asm volatile("" : "+v"(R.cb[0]), "+v"(R.cb[1]), "+v"(R.cb[2]), "+v"(R.cbd), "+v"(R.cc[0]), "+v"(R.cc[1]), "+v"(R.cc[2]), "+v"(R.cc[3]), "+v"(R.bt[0]), "+v"(R.bt[1]), "+v"(R.bt[2]), "+v"(R.bt[3]), "+v"(R.zz[0]), "+v"(R.zz[1]), "+v"(R.dt))
#define P2B_TOUCH_S(R) asm volatile("" : "+v"(R.raw[0]), "+v"(R.raw[1]), "+v"(R.raw[2]), "+v"(R.raw[3]), "+v"(R.dt), "+v"(R.ac), "+v"(R.aend), "+v"(R.atot))
    P2bStageRegs SRa, SRb; P2bCompRegs CRa, CRb;
    LAS unsigned char* L0 = F.lds; LAS unsigned char* L1 = F.lds + P2B_BUF;
    P2B_LOAD_STAGE(SRa, true); P2B_LOAD_COMP(CRa); P2B_LOAD_STAGE(SRb, false);
    P2B_STAGE(SRa, L0);
    LDS_BAR();
#ifndef P2B_ABL
#define P2B_ABL 0
#endif
    for (int c = 0; c < 32; c += 2) {
        P2B_TOUCH_C(CRa); P2B_TOUCH_S(SRb);
        if (!(P2B_ABL & 1)) { P2B_LOAD_COMP(CRb); if (c + 2 < 32) P2B_LOAD_STAGE(SRa, false); }
        __builtin_amdgcn_sched_barrier(0);
        if (!(P2B_ABL & 2)) P2B_COMPUTE(CRa, L0, L1); else { if (fq == 0) *q_ssq = 32.f; q_ssq += CHUNK * 64; }
        if (!(P2B_ABL & 4)) P2B_STAGE(SRb, L1);
        LDS_BAR();
        P2B_TOUCH_C(CRb); P2B_TOUCH_S(SRa);
        if (!(P2B_ABL & 1)) if (c + 2 < 32) { P2B_LOAD_COMP(CRa); if (c + 3 < 32) P2B_LOAD_STAGE(SRb, false); }
        __builtin_amdgcn_sched_barrier(0);
        if (!(P2B_ABL & 2)) P2B_COMPUTE(CRb, L1, L0); else { if (fq == 0) *q_ssq = 32.f; q_ssq += CHUNK * 64; }
        if (!(P2B_ABL & 4)) if (c + 2 < 32) P2B_STAGE(SRa, L0);
        LDS_BAR();
    }
#undef P2B_TOUCH_C
#undef P2B_TOUCH_S
#undef P2B_COMPUTE
#undef P2B_LOAD_STAGE
#undef P2B_LOAD_COMP
#undef P2B_STAGE
}

struct SchedP3 {
    const char* A; const char* B; int pm, pn;
    __device__ __forceinline__ bool next(int i, Unit& u) const {
        if (i >= 4) return false;
        u.pm = pm; u.pn = pn; u.kind = i;
        const int acol = (i == 1) ? 1024 : (i == 3 ? 3072 : 0), bcol = (i == 0) ? 0 : (i == 1 ? 1024 : (i == 2 ? 4096 : 3072));
        u.nt = (i == 1) ? 32 : 16;
        u.A = A + ((size_t)pm * 256 * ACAT_LD + acol) * 2; u.B = B + ((size_t)pn * 256 * BCAT_LD + bcol) * 2; return true;
    }
};
struct EpiP3 {
    static constexpr bool PERM = true;
    bf16_t* G; bf16_t* T; const float* b_gate; const float* SSQ;
    __device__ __forceinline__ void operator()(const f32x4 (&acc)[2][2][4][2], const Unit& u, int wr, int wc, int fr, int fq) const {
        const int row0 = u.pm * 256 + wr * 64 + fr, ct = u.pn * 256 + wc * 32 + 8 * fq;
        if (u.kind == 0 || u.kind == 2) {
            const float* bg = b_gate + (u.kind == 2 ? 1024 : 0);
#pragma unroll
            for (int bj = 0; bj < 2; ++bj) { const int c = ct + bj * 128; const f32x4 b0 = *(const f32x4*)(bg + c), b1 = *(const f32x4*)(bg + c + 4);
#pragma unroll
                for (int ai = 0; ai < 2; ++ai)
#pragma unroll
                    for (int m = 0; m < 4; ++m) { const int r = row0 + ai * 128 + m * 16; const f32x4 v0 = acc[ai][bj][m][0] + b0, v1 = acc[ai][bj][m][1] + b1; u32x4 w;
                        w.x = cvt_pk_bf16(fast_sigmoid(v0[0]), fast_sigmoid(v0[1])); w.y = cvt_pk_bf16(fast_sigmoid(v0[2]), fast_sigmoid(v0[3]));
                        w.z = cvt_pk_bf16(fast_sigmoid(v1[0]), fast_sigmoid(v1[1])); w.w = cvt_pk_bf16(fast_sigmoid(v1[2]), fast_sigmoid(v1[3]));
                        *(u32x4*)(G + (size_t)r * D + c) = w; } }
        } else if (u.kind == 1) {
#pragma unroll
            for (int ai = 0; ai < 2; ++ai)
#pragma unroll
                for (int m = 0; m < 4; ++m) { const int r = row0 + ai * 128 + m * 16;
                    float ss = 0.f;
#pragma unroll
                    for (int j = 0; j < 4; ++j) { const f32x4 p = *(const f32x4*)(SSQ + (size_t)r * 64 + fq * 16 + j * 4); ss += (p[0] + p[1]) + (p[2] + p[3]); }
                    ss += __shfl_xor(ss, 16); ss += __shfl_xor(ss, 32);
                    const float rs = 1.0f / sqrtf(ss * (1.0f / DI) + NORM_EPS);
#pragma unroll
                    for (int bj = 0; bj < 2; ++bj) { const int c = ct + bj * 128; const u32x4 g = *(const u32x4*)(G + (size_t)r * D + c); const f32x4 v0 = acc[ai][bj][m][0] * rs, v1 = acc[ai][bj][m][1] * rs; u32x4 w;
                        w.x = cvt_pk_bf16(bf_lo(g.x) * v0[0], bf_hi(g.x) * v0[1]); w.y = cvt_pk_bf16(bf_lo(g.y) * v0[2], bf_hi(g.y) * v0[3]);
                        w.z = cvt_pk_bf16(bf_lo(g.z) * v1[0], bf_hi(g.z) * v1[1]); w.w = cvt_pk_bf16(bf_lo(g.w) * v1[2], bf_hi(g.w) * v1[3]);
                        *(u32x4*)(T + (size_t)r * D + c) = w; } }
        } else {
#pragma unroll
            for (int ai = 0; ai < 2; ++ai)
#pragma unroll
                for (int m = 0; m < 4; ++m) { const int r = row0 + ai * 128 + m * 16;
#pragma unroll
                    for (int bj = 0; bj < 2; ++bj) { const int c = ct + bj * 128; const u32x4 g = *(const u32x4*)(G + (size_t)r * D + c); const u32x4 t = *(const u32x4*)(T + (size_t)r * D + c);
                        const f32x4 v0 = acc[ai][bj][m][0], v1 = acc[ai][bj][m][1]; u32x4 w;
                        w.x = cvt_pk_bf16(bf_lo(t.x) + bf_lo(g.x) * v0[0], bf_hi(t.x) + bf_hi(g.x) * v0[1]); w.y = cvt_pk_bf16(bf_lo(t.y) + bf_lo(g.y) * v0[2], bf_hi(t.y) + bf_hi(g.y) * v0[3]);
                        w.z = cvt_pk_bf16(bf_lo(t.z) + bf_lo(g.z) * v1[0], bf_hi(t.z) + bf_hi(g.z) * v1[1]); w.w = cvt_pk_bf16(bf_lo(t.w) + bf_lo(g.w) * v1[2], bf_hi(t.w) + bf_hi(g.w) * v1[3]);
                        *(u32x4*)(T + (size_t)r * D + c) = w; } }
        }
    }
};

struct SchedSq {
    const char* A; const char* B; int lda, K, c;
    __device__ __forceinline__ bool next(int i, Unit& u) const {
        if (i >= 1 || c >= 256) return false;
        pg8::tile_of(c, 64, 4, u.pm, u.pn); u.nt = K / 64; u.kind = 0;
        u.A = A + (size_t)u.pm * 256 * lda * 2; u.B = B + (size_t)u.pn * 256 * K * 2; return true;
    }
};
template <bool WRITE_BF16> struct EpiRes {
    static constexpr bool PERM = false;
    const float* base; float* out; bf16_t* ob; float* SS;
    __device__ __forceinline__ void operator()(const f32x4 (&acc)[2][2][4][2], const Unit& u, int wr, int wc, int fr, int fq) const {
        const int row0 = u.pm * 256 + wr * 64 + fr, col0 = u.pn * 256 + wc * 32 + 4 * fq;
#pragma unroll
        for (int ai = 0; ai < 2; ++ai)
#pragma unroll
            for (int m = 0; m < 4; ++m) { const int r = row0 + ai * 128 + m * 16; const size_t off = (size_t)r * D + col0; float q = 0.f;
#pragma unroll
                for (int bj = 0; bj < 2; ++bj)
#pragma unroll
                    for (int n = 0; n < 2; ++n) { const size_t o = off + bj * 128 + n * 16; const f32x4 h = *(const f32x4*)(base + o) + acc[ai][bj][m][n];
                        *(f32x4*)(out + o) = h; q += (h[0] * h[0] + h[1] * h[1]) + (h[2] * h[2] + h[3] * h[3]);
                        if (WRITE_BF16) { u32x2 w; w.x = cvt_pk_bf16(h[0], h[1]); w.y = cvt_pk_bf16(h[2], h[3]); *(u32x2*)(ob + o) = w; } }
                q += __shfl_xor(q, 16); q += __shfl_xor(q, 32);
                if (fq == 0) SS[(size_t)r * 16 + u.pn * 4 + wc] = q; }
    }
};

struct SchedP5 {
    const char* A; const char* B; int G, c;
    __device__ __forceinline__ bool next(int i, Unit& u) const {
        const int L = i * G + c; if (L >= 68 * 22) return false;
        pg8::tile_of(L, 68, 22, u.pm, u.pn); u.nt = D / 64;
        const int q = u.pm / 17, ii = u.pm % 17, o = ii < 16 ? 248 * ii : SEQ - 248;
        u.kind = q * SEQ + o;
        u.A = A + ((long)u.kind - 2) * (long)(D * 2); u.B = B + (size_t)u.pn * 256 * D * 2; return true;
    }
};
template <int CTRL> __device__ __forceinline__ float dpp_keep(float oldv, float x) { return __builtin_bit_cast(float, __builtin_amdgcn_update_dpp(__builtin_bit_cast(int, oldv), __builtin_bit_cast(int, x), CTRL, 0xf, 0xf, false)); }
struct EpiP5 {
    static constexpr bool PERM = true;
    bf16_t* ACT; const float* SS2; const float* cw; const float* cb;
    __device__ __forceinline__ void operator()(f32x4 (&acc)[2][2][4][2], const Unit& u, int wr, int wc, int fr, int fq) const {
        const int tok0 = u.kind, ii = u.pm % 17; const int skip = ii < 16 ? 0 : 120; const bool first = (ii == 0);
        const int j0 = u.pn * 128 + wc * 32 + 8 * fq;
#pragma unroll
        for (int ai = 0; ai < 2; ++ai)
#pragma unroll
            for (int m = 0; m < 4; ++m) { const int blk = 2 * ai + wr, lr = 16 * m + fr; const int tok = tok0 + 62 * blk + lr - 2;
                const bool zero = first && blk == 0 && lr < 2;
                const int tokc = zero ? tok0 : tok;
                const f32x4 p = *(const f32x4*)(SS2 + (size_t)tokc * 16 + 4 * fq); float ss = (p[0] + p[1]) + (p[2] + p[3]);
                ss += __shfl_xor(ss, 16); ss += __shfl_xor(ss, 32);
                const float rs = 1.0f / sqrtf(ss * (1.0f / D) + NORM_EPS);
#pragma unroll
                for (int bj = 0; bj < 2; ++bj)
#pragma unroll
                    for (int n = 0; n < 2; ++n) acc[ai][bj][m][n] = zero ? (f32x4){0.f, 0.f, 0.f, 0.f} : acc[ai][bj][m][n] * rs; }
#pragma unroll
        for (int n = 0; n < 2; ++n) {
            f32x4 w0[2], w1[2], w2[2], bb[2];
#pragma unroll
            for (int bj = 0; bj < 2; ++bj) { const int ch = bj * FF + j0 + 4 * n; w0[bj] = *(const f32x4*)(cw + ch); w1[bj] = *(const f32x4*)(cw + 2 * FF + ch); w2[bj] = *(const f32x4*)(cw + 4 * FF + ch); bb[bj] = *(const f32x4*)(cb + ch); }
#pragma unroll
            for (int ai = 0; ai < 2; ++ai) { const int blk = 2 * ai + wr;
#pragma unroll
                for (int m = 3; m >= 0; --m) {
                    f32x4 cv[2];
#pragma unroll
                    for (int bj = 0; bj < 2; ++bj) {
#pragma unroll
                        for (int i = 0; i < 4; ++i) { const float x = acc[ai][bj][m][n][i]; const float xp = m > 0 ? acc[ai][bj][m - 1][n][i] : 0.f;
                            const float s1 = dpp_keep<0x111>(dpp_keep<0x121>(0.f, xp), x);
                            const float s2 = dpp_keep<0x112>(dpp_keep<0x122>(0.f, xp), x);
                            cv[bj][i] = bb[bj][i] + w2[bj][i] * x + w1[bj][i] * s1 + w0[bj][i] * s2; } }
                    const int lr = 16 * m + fr, oi = 62 * blk + lr - 2;
                    u32x2 w; w.x = cvt_pk_bf16(fast_silu(cv[0][0]) * cv[1][0], fast_silu(cv[0][1]) * cv[1][1]); w.y = cvt_pk_bf16(fast_silu(cv[0][2]) * cv[1][2], fast_silu(cv[0][3]) * cv[1][3]);
                    if (lr >= 2 && oi >= skip) *(u32x2*)(ACT + (size_t)(tok0 + oi) * FF + j0 + 4 * n) = w;
                    asm volatile("" ::: "memory");
                }
            }
        }
    }
};

__device__ __forceinline__ void p7_final(Frame& F) {
    const float* SS3 = (const float*)(F.ws + WS_SS3); const float* fw = F.in[22];
    const int gw = F.vcu * NWAVES + F.wave, NGW = F.G * NWAVES, lane = F.lane;
    f32x4 wv[4];
#pragma unroll
    for (int j = 0; j < 4; ++j) wv[j] = *((const f32x4*)fw + lane + 64 * j);
    for (int m = gw; m < M; m += NGW) {
        float ss = lane < 16 ? SS3[(size_t)m * 16 + lane] : 0.f; ss = wave_sum(ss);
        const float rs = 1.0f / sqrtf(ss * (1.0f / D) + NORM_EPS);
        GAS f32x4* o = (GAS f32x4*)(F.out + (size_t)m * D) + lane;
#pragma unroll
        for (int j = 0; j < 4; ++j) { f32x4 v = o[64 * j]; v = v * rs * wv[j]; o[64 * j] = v; }
    }
}

struct Args { const float* in[23]; float* out; unsigned char* ws; int ph_lo, ph_hi, li, pad; };
__global__ void __launch_bounds__(NWAVES * 64, 2) mk_fwd(Args args) {
    extern __shared__ __attribute__((aligned(16))) unsigned char lds[];
    Frame F;
    F.lds = (LAS unsigned char*)lds; F.MISC = (volatile LAS unsigned*)(F.lds + MISC_OFF);
    F.tid = threadIdx.x; F.lane = F.tid & 63; F.wave = __builtin_amdgcn_readfirstlane(F.tid >> 6);
    F.G = gridDim.x; { const int bx = blockIdx.x; F.vcu = (F.G % 8 == 0) ? (bx % 8) * (F.G / 8) + bx / 8 : bx; }
#pragma unroll
    for (int i = 0; i < 23; ++i) F.in[i] = args.in[i];
    F.out = args.out; F.ws = args.ws; F.ctl = (gu32*)(args.ws + WS_CTL);
    for (int u = F.tid; u < (LDS_BYTES - LDSCTL_OFF) / 4; u += NWAVES * 64) ((LAS unsigned*)(F.lds + LDSCTL_OFF))[u] = 0u;
    __syncthreads();
    XcdBarrier bar; bar.bar = (unsigned*)(F.ctl + CW_BAR); bar.x = 0; bar.st = nullptr;
    if (MK_N_LAUNCHES == 1) bar = xcd_barrier_post((unsigned*)(F.ctl + CW_BAR), F.MISC + 8);
#ifndef DBG_TSA
#define DBG_TSA -1
#endif
#ifndef DBG_TSB
#define DBG_TSB -1
#endif
#ifndef DBG_TSQ
#define DBG_TSQ 0
#endif
#ifndef DBG_TSSCALE
#define DBG_TSSCALE 1e-4f
#endif
    int n_stamp = 0;
#define STAMP() do { if ((DBG_TSA >= 0 || DBG_TSB >= 0) && blockIdx.x == 0 && F.tid == 0) { const unsigned long long t_ = __builtin_amdgcn_s_memrealtime(); F.MISC[16 + 2 * n_stamp] = (unsigned)t_; F.MISC[17 + 2 * n_stamp] = (unsigned)(t_ >> 32); } ++n_stamp; } while (0)
#define GRID_BAR() do { if (MK_N_LAUNCHES == 1) xcd_barrier(bar); STAMP(); } while (0)
    STAMP();
#if defined(DBG_PLACE)
    if (F.tid == 0) __hip_atomic_fetch_or((unsigned*)(F.ctl + 2048 + 64 * (blockIdx.x % 8)), 1u << xb_xcc_id(), RLX_AGENT);
#endif
    const int lo = args.ph_lo, hi = args.ph_hi;
#ifndef PH_MASK
#define PH_MASK 0xff
#endif
#define IN(k) (((PH_MASK >> (k)) & 1) && lo <= (k) && (k) < hi)
    unsigned char* dout = (unsigned char*)F.out;

    if (IN(0)) { p0_prologue(F); GRID_BAR(); }
    if (IN(1)) {
        SchedP1 S{(const char*)(F.ws + WS_ACAT), (const char*)(dout + DO_W1T), F.G, (int)blockIdx.x};
        EpiP1 E{(bf16_t*)(F.ws + WS_ACAT), (bf16_t*)(F.ws + WS_XBC), (bf16_t*)(dout + DO_V), (bf16_t*)(dout + DO_HALO), (float*)(dout + DO_VST), F.in[10]};
        pg8::gemm_phase<EpiP1, SchedP1, true, false>(F.lds, ACAT_LD, D, S, E);
        p1_dt(F);
        GRID_BAR();
    }
#if NAIVE_P2
    if (IN(2)) { p2_naive(F); GRID_BAR(); }
#else
    if (IN(2)) { p2a_phase(F); GRID_BAR(); p2b_chain(F); GRID_BAR(); }
#endif
    if (IN(3)) {
        int pm, pn; pg8::tile_of((int)blockIdx.x, 64, 4, pm, pn);
        SchedP3 S{(const char*)(F.ws + WS_ACAT), (const char*)(F.ws + WS_BCAT), pm, pn};
        EpiP3 E{(bf16_t*)(F.ws + WS_G), (bf16_t*)(F.ws + WS_T), F.in[3], (const float*)(dout + DO_SSQ)};
        if (blockIdx.x < 256) pg8::gemm_phase<EpiP3, SchedP3, true, false>(F.lds, ACAT_LD, BCAT_LD, S, E);
        GRID_BAR();
    }
    if (IN(4)) {
        SchedSq S{(const char*)(F.ws + WS_T), (const char*)(F.ws + WS_WOUT), D, D, (int)blockIdx.x};
        EpiRes<true> E{F.in[0], (float*)(F.ws + WS_H), (bf16_t*)(F.ws + WS_HB), (float*)(F.ws + WS_SS2)};
        pg8::gemm_phase<EpiRes<true>, SchedSq, true, false>(F.lds, D, D, S, E);
        GRID_BAR();
    }
    if (IN(5)) {
        SchedP5 S{(const char*)(F.ws + WS_HB), (const char*)(F.ws + WS_WUP), F.G, (int)blockIdx.x};
        EpiP5 E{(bf16_t*)(F.ws + WS_ACT), (const float*)(F.ws + WS_SS2), F.in[19], F.in[20]};
        pg8::gemm_phase<EpiP5, SchedP5, true, true>(F.lds, D, D, S, E);
        GRID_BAR();
    }
    if (IN(6)) {
        SchedSq S{(const char*)(F.ws + WS_ACT), (const char*)(F.ws + WS_WDOWN), FF, FF, (int)blockIdx.x};
        EpiRes<false> E{(const float*)(F.ws + WS_H), F.out, nullptr, (float*)(F.ws + WS_SS3)};
        pg8::gemm_phase<EpiRes<false>, SchedSq, true, false>(F.lds, FF, FF, S, E);
        GRID_BAR();
    }
    if (IN(7)) { p7_final(F); STAMP(); }
#if defined(DBG_PLACE)
    xcd_barrier(bar);
    if (blockIdx.x == 0 && F.tid == 0) { int pc_ = 0; for (int j = 0; j < 8; ++j) pc_ += __builtin_popcount(__hip_atomic_load((unsigned*)(F.ctl + 2048 + 64 * j), RLX_AGENT)); F.out[0] += (float)pc_ * 0.1f; }
#endif
    if (DBG_TSA >= 0 || DBG_TSB >= 0) xcd_barrier(bar);
    if ((DBG_TSA >= 0 || DBG_TSB >= 0) && blockIdx.x == 0) {
        __syncthreads();
        if (DBG_TSA >= 0 && F.tid == 0) { const unsigned long long t0 = ((unsigned long long)F.MISC[17 + 2 * DBG_TSA] << 32) | F.MISC[16 + 2 * DBG_TSA], t1 = ((unsigned long long)F.MISC[19 + 2 * DBG_TSA] << 32) | F.MISC[18 + 2 * DBG_TSA];
            F.out[0] += (DBG_TSQ > 0 ? (float)(((t1 - t0) + DBG_TSQ / 2) / DBG_TSQ * DBG_TSQ) : (float)(t1 - t0)) * DBG_TSSCALE; }
        if (DBG_TSB >= 0 && F.tid >= 64) { const unsigned long long t0 = ((unsigned long long)F.MISC[17 + 2 * DBG_TSB] << 32) | F.MISC[16 + 2 * DBG_TSB], t1 = ((unsigned long long)F.MISC[19 + 2 * DBG_TSB] << 32) | F.MISC[18 + 2 * DBG_TSB];
            const float dl = (float)(t1 - t0) * 1e-5f; for (int i = F.tid - 64; i < 65536; i += 448) F.out[(size_t)M * D - 65536 + i] += dl; }
    }
#undef IN
#undef GRID_BAR
}

__global__ void __launch_bounds__(64) ssd_naive(const bf16_t* XBC, const float* DT, bf16_t* ACAT, float* SSQ,
                                               const float* conv_w, const float* conv_b, const float* a_log, const float* d_skip) {
    __shared__ float sB[2][NS], sC[2][NS];
    const int b = blockIdx.x >> 5, h = blockIdx.x & 31, g = h >> 3, p = threadIdx.x;
    const float a = -expf(a_log[h]), dsk = d_skip[h];
    const int chx = h * HD + p;
    int ch[4]; ch[0] = DI + g * NS + p; ch[1] = ch[0] + 64; ch[2] = DI + NG * NS + g * NS + p; ch[3] = ch[2] + 64;
    float wx[4], wq[4][4]; const float bx = conv_b[chx]; float bq[4];
#pragma unroll
    for (int k = 0; k < 4; ++k) wx[k] = conv_w[k * XBCW + chx];
#pragma unroll
    for (int j = 0; j < 4; ++j) { bq[j] = conv_b[ch[j]];
#pragma unroll
        for (int k = 0; k < 4; ++k) wq[j][k] = conv_w[k * XBCW + ch[j]]; }
    float hs[NS];
#pragma unroll
    for (int n = 0; n < NS; ++n) hs[n] = 0.f;
    float xh[3] = {0.f, 0.f, 0.f}, qh[4][3];
#pragma unroll
    for (int j = 0; j < 4; ++j) { qh[j][0] = 0.f; qh[j][1] = 0.f; qh[j][2] = 0.f; }
    size_t row = (size_t)b * SEQ;
    bf16_t nx = XBC[row * XBCW + chx], nq[4];
#pragma unroll
    for (int j = 0; j < 4; ++j) nq[j] = XBC[row * XBCW + ch[j]];
    float ndt = DT[row * NH + h]; bf16_t nz = ACAT[row * ACAT_LD + 1024 + chx];
    for (int t = 0; t < SEQ; ++t) {
        row = (size_t)b * SEQ + t;
        const float xc = bf2f(nx); float qc[4];
#pragma unroll
        for (int j = 0; j < 4; ++j) qc[j] = bf2f(nq[j]);
        const float dt = ndt; const float zs = bf2f(nz);
        if (t + 1 < SEQ) { const size_t r1 = row + 1; nx = XBC[r1 * XBCW + chx];
#pragma unroll
            for (int j = 0; j < 4; ++j) nq[j] = XBC[r1 * XBCW + ch[j]];
            ndt = DT[r1 * NH + h]; nz = ACAT[r1 * ACAT_LD + 1024 + chx]; }
        const float xv = fast_silu(bx + wx[0] * xh[0] + wx[1] * xh[1] + wx[2] * xh[2] + wx[3] * xc);
        xh[0] = xh[1]; xh[1] = xh[2]; xh[2] = xc;
        const int buf = t & 1;
#pragma unroll
        for (int j = 0; j < 4; ++j) { const float v = fast_silu(bq[j] + wq[j][0] * qh[j][0] + wq[j][1] * qh[j][1] + wq[j][2] * qh[j][2] + wq[j][3] * qc[j]);
            qh[j][0] = qh[j][1]; qh[j][1] = qh[j][2]; qh[j][2] = qc[j];
            if (j < 2) sB[buf][p + 64 * j] = v; else sC[buf][p + 64 * (j - 2)] = v; }
        __syncthreads();
        const float dA = expf(dt * a), xdt = xv * dt; float y = 0.f;
#pragma unroll
        for (int n = 0; n < NS; n += 4) { const f32x4 Bv = *(const f32x4*)&sB[buf][n], Cv = *(const f32x4*)&sC[buf][n];
#pragma unroll
            for (int i = 0; i < 4; ++i) { hs[n + i] = hs[n + i] * dA + xdt * Bv[i]; y += Cv[i] * hs[n + i]; } }
        y += dsk * xv;
        const float yz = y * zs;
        ACAT[row * ACAT_LD + 1024 + chx] = (bf16_t)f2bf(yz);
        const float ssq = wave_sum(yz * yz);
        if (p == 0) { SSQ[row * 64 + 2 * h] = ssq; SSQ[row * 64 + 2 * h + 1] = 0.f; }
    }
}
__global__ void __launch_bounds__(64) sgu_naive(const bf16_t* V, const float* VST, bf16_t* ACAT, const float* ln_w, const float* ln_b, const float* w_sp, const float* b_sp) {
    __shared__ float sv[CHUNK][64];
    __shared__ float smean[CHUNK], srstd[CHUNK];
    const int bc = blockIdx.x >> 4, g = (blockIdx.x >> 1) & 7, d = (blockIdx.x & 1) * 64 + threadIdx.x; const size_t row0 = (size_t)bc * CHUNK;
    for (int s = threadIdx.x; s < CHUNK; s += 64) { float su = 0.f, sq = 0.f;
        for (int j = 0; j < 16; ++j) { su += VST[((row0 + s) * 16 + j) * 2]; sq += VST[((row0 + s) * 16 + j) * 2 + 1]; }
        const float mu = su * (1.0f / D); const float var = fmaxf(sq * (1.0f / D) - mu * mu, 0.f); smean[s] = mu; srstd[s] = 1.0f / sqrtf(var + LN_EPS); }
    __syncthreads();
    const float lw = ln_w[g * NS + d], lb = ln_b[g * NS + d];
    for (int s = 0; s < CHUNK; ++s) sv[s][threadIdx.x] = (bf2f(V[(row0 + s) * D + g * NS + d]) - smean[s]) * srstd[s] * lw + lb;
    __syncthreads();
    for (int t = 0; t < CHUNK; ++t) { const float* wr = w_sp + ((size_t)g * CHUNK + t) * CHUNK; float mix = b_sp[g * CHUNK + t];
        for (int s = 0; s <= t; ++s) mix += wr[s] * sv[s][threadIdx.x];
        bf16_t* up = ACAT + (row0 + t) * ACAT_LD + 3072 + g * NS + d;
        *up = (bf16_t)f2bf(bf2f(*up) * mix); }
}

#ifndef DBG_STOP
#define DBG_STOP 0
#endif
#if DBG_STOP
__global__ void dbg_digest(const unsigned char* dout, float* dig, int which) {
    const int row = blockIdx.x * blockDim.x + threadIdx.x; if (row >= M) return; float s = 0.f;
    if (which == 1) { const bf16_t* V = (const bf16_t*)(dout + DO_V); const float* DT = (const float*)(dout + DO_DT); const float* VST = (const float*)(dout + DO_VST);
        for (int c = 0; c < D; ++c) s += bf2f(V[(size_t)row * D + c]); for (int c = 0; c < NH; ++c) s += DT[(size_t)row * NH + c]; for (int c = 0; c < 32; ++c) s += 1e-3f * VST[(size_t)row * 32 + c]; }
    else { const float* SSQ = (const float*)(dout + DO_SSQ); for (int c = 0; c < 64; ++c) s += SSQ[(size_t)row * 64 + c]; }
    dig[row] = s;
}
__global__ void dbg_dump(const unsigned char* ws, float* out, const float* dig, int which) {
    const size_t i = (size_t)blockIdx.x * blockDim.x + threadIdx.x; if (i >= (size_t)M * D) return; const size_t row = i / D; const int c = (int)(i % D); float v = 0.f;
    const bf16_t* XBC = (const bf16_t*)(ws + WS_XBC); const bf16_t* ACAT = (const bf16_t*)(ws + WS_ACAT);
    if (which == 1) { v = bf2f(XBC[row * XBCW + c]) + bf2f(XBC[row * XBCW + 1024 + c]) + bf2f(XBC[row * XBCW + 2048 + c]) + bf2f(ACAT[row * ACAT_LD + c]) + bf2f(ACAT[row * ACAT_LD + 1024 + c]) + bf2f(ACAT[row * ACAT_LD + 2048 + c]) + bf2f(ACAT[row * ACAT_LD + 3072 + c]) + dig[row]; }
    else if (which == 2) { v = bf2f(ACAT[row * ACAT_LD + 1024 + c]) + bf2f(ACAT[row * ACAT_LD + 2048 + c]) + bf2f(ACAT[row * ACAT_LD + 3072 + c]) + 1e-3f * dig[row]; }
    else if (which == 3) { v = bf2f(((const bf16_t*)(ws + WS_T))[i]); }
    else if (which == 4) { v = ((const float*)(ws + WS_H))[i] + bf2f(((const bf16_t*)(ws + WS_HB))[i]); }
    else if (which == 5) { const bf16_t* A = (const bf16_t*)(ws + WS_ACT); v = bf2f(A[row * FF + c]) + bf2f(A[row * FF + 1024 + c]) + bf2f(A[row * FF + 1792 + c]); }
    out[i] = v;
}
#endif

extern "C" void kernel_launch(void* const* d_in, const int* in_sizes, int n_in, void* d_out, int out_size, void* d_ws, size_t ws_size, hipStream_t stream) {
    static int grid = 0;
    if (grid == 0) {
        if (n_in != 23 || in_sizes[0] != M * D || out_size != M * D || ws_size < WS_END) { fprintf(stderr, "kernel_launch: unexpected shapes (n_in %d, in0 %d, out %d, ws %zu)\n", n_in, n_in > 0 ? in_sizes[0] : -1, out_size, ws_size); grid = -1; return; }
        int dev = 0, cus = 0, per_cu = 0;
        if (hipGetDevice(&dev) != hipSuccess || hipDeviceGetAttribute(&cus, hipDeviceAttributeMultiprocessorCount, dev) != hipSuccess) { grid = -1; return; }
        if (hipFuncSetAttribute((const void*)mk_fwd, hipFuncAttributeMaxDynamicSharedMemorySize, LDS_BYTES) != hipSuccess) { fprintf(stderr, "kernel_launch: hipFuncSetAttribute failed\n"); grid = -1; return; }
        if (hipOccupancyMaxActiveBlocksPerMultiprocessor(&per_cu, (const void*)mk_fwd, NWAVES * 64, LDS_BYTES) != hipSuccess || per_cu < 1) { fprintf(stderr, "kernel_launch: occupancy query says %d blocks per CU\n", per_cu); (void)hipGetLastError(); grid = -1; return; }
        grid = cus;
        if (grid != 256) fprintf(stderr, "kernel_launch: %d CUs (built for 256)\n", grid);
    }
    if (grid < 0) return;
    (void)hipMemsetAsync((char*)d_ws + WS_CTL, 0, CTL_ZERO_BYTES, stream);
    Args a{};
    for (int i = 0; i < 23; ++i) a.in[i] = (const float*)d_in[i];
    a.out = (float*)d_out; a.ws = (unsigned char*)d_ws;
    unsigned char* dout = (unsigned char*)d_out; unsigned char* ws = (unsigned char*)d_ws;
#if MK_N_LAUNCHES == 1
    a.ph_lo = 0; a.ph_hi = 8; a.li = 0;
    hipLaunchKernelGGL(mk_fwd, dim3(grid), dim3(NWAVES * 64), LDS_BYTES, stream, a);
#else
    for (int ph = 0; ph < 8; ++ph) {
        if (ph == 2) {
            hipLaunchKernelGGL(ssd_naive, dim3(BATCH * NH), dim3(64), 0, stream, (const bf16_t*)(ws + WS_XBC), (const float*)(dout + DO_DT), (bf16_t*)(ws + WS_ACAT), (float*)(dout + DO_SSQ),
                               (const float*)d_in[4], (const float*)d_in[5], (const float*)d_in[7], (const float*)d_in[8]);
            hipLaunchKernelGGL(sgu_naive, dim3(M / CHUNK * 16), dim3(64), 0, stream, (const bf16_t*)(dout + DO_V), (const float*)(dout + DO_VST), (bf16_t*)(ws + WS_ACAT),
                               (const float*)d_in[11], (const float*)d_in[12], (const float*)d_in[13], (const float*)d_in[14]);
#if DBG_STOP == 2
            { float* dig = (float*)(ws + WS_SS2); hipLaunchKernelGGL(dbg_digest, dim3(M / 256), dim3(256), 0, stream, (const unsigned char*)dout, dig, 2);
              hipLaunchKernelGGL(dbg_dump, dim3(M * D / 256), dim3(256), 0, stream, (const unsigned char*)ws, (float*)d_out, (const float*)dig, 2); break; }
#endif
            continue;
        }
        a.ph_lo = ph; a.ph_hi = ph + 1; a.li = ph;
        hipLaunchKernelGGL(mk_fwd, dim3(grid), dim3(NWAVES * 64), LDS_BYTES, stream, a);
#if DBG_STOP
        if (ph == DBG_STOP && DBG_STOP != 2) { float* dig = (float*)(ws + WS_SS2);
            if (DBG_STOP == 1) hipLaunchKernelGGL(dbg_digest, dim3(M / 256), dim3(256), 0, stream, (const unsigned char*)dout, dig, 1);
            hipLaunchKernelGGL(dbg_dump, dim3(M * D / 256), dim3(256), 0, stream, (const unsigned char*)ws, (float*)d_out, (const float*)dig, DBG_STOP); break; }
#endif
    }
#endif
}
```
